# Optimizing an MI355X kernel written in HIP

```python
import math
import jax, jax.numpy as jnp
from jax import lax
import numpy as np

D_MODEL = 1024
BATCH = 8
SEQ = 2048
DEPTH = 2

CONV_WIDTH = D_MODEL
CONV_K = 3
HEAD_DIM = 64
V_HEAD_DIM = 2 * HEAD_DIM
N_DIFF_HEADS = D_MODEL // V_HEAD_DIM
QK_WIDTH = N_DIFF_HEADS * 2 * HEAD_DIM
ATTN_WIDTH = N_DIFF_HEADS * V_HEAD_DIM
ROT_DIM = HEAD_DIM // 4
ROPE_THETA = 500000.0
Q_BLOCK = 128
D_FF = ((8 * D_MODEL // 3 + 255) // 256) * 256
NORM_EPS = 1e-6
N_BRANCHES = 2
IN_WIDTH = 3 * CONV_WIDTH + 2 * QK_WIDTH + ATTN_WIDTH + N_BRANCHES * D_MODEL

kernel_name = "hybrid_gated_conv_diffattn_macaron_encoder"


def rmsnorm(x, w):
    xf = x.astype(jnp.float32)
    y = xf * lax.rsqrt(jnp.mean(xf * xf, axis=-1, keepdims=True) + NORM_EPS)
    return (y * w.astype(jnp.float32)).astype(x.dtype)


def swiglu(x, w13, w2):
    g, u = jnp.split(x @ w13, 2, axis=-1)
    return (jax.nn.silu(g) * u) @ w2


def rope_tables(seq_len):
    pos = jnp.arange(seq_len, dtype=jnp.float32)
    inv = ROPE_THETA ** (-jnp.arange(0, ROT_DIM, 2, dtype=jnp.float32) / ROT_DIM)
    ang = pos[:, None] * inv[None, :]
    return jnp.cos(ang), jnp.sin(ang)


def apply_partial_rope(t, cos, sin):
    c = cos[None, :, None, None, :].astype(t.dtype)
    s = sin[None, :, None, None, :].astype(t.dtype)
    half = ROT_DIM // 2
    t1 = t[..., :half]
    t2 = t[..., half:ROT_DIM]
    return jnp.concatenate([t1 * c - t2 * s, t2 * c + t1 * s, t[..., ROT_DIM:]], axis=-1)


def short_conv(u, w):
    up = jnp.pad(u, ((0, 0), (1, 1), (0, 0)))
    s = u.shape[1]
    return up[:, 0:s] * w[0] + up[:, 1:s + 1] * w[1] + up[:, 2:s + 2] * w[2]


def diff_attention(q, k, v, lam, lam_init, subln_w):
    b, s = q.shape[0], q.shape[1]
    nb = s // Q_BLOCK
    qb = q.reshape(b, nb, Q_BLOCK, N_DIFF_HEADS, 2, HEAD_DIM).transpose(1, 0, 3, 4, 2, 5)
    kt = k.transpose(0, 2, 3, 1, 4)
    vt = v.transpose(0, 2, 1, 3)
    scale = HEAD_DIM ** -0.5

    def block(qblk):
        sc = jnp.einsum('bhcqd,bhckd->bhcqk', qblk, kt).astype(jnp.float32) * scale
        p = jax.nn.softmax(sc, axis=-1)
        a = p[:, :, 0] - lam * p[:, :, 1]
        return jnp.einsum('bhqk,bhkd->bhqd', a.astype(vt.dtype), vt)

    o = lax.map(block, qb)
    o = o.transpose(1, 0, 3, 2, 4).reshape(b, s, N_DIFF_HEADS, V_HEAD_DIM)
    o = rmsnorm(o, subln_w) * (1.0 - lam_init)
    return o.reshape(b, s, ATTN_WIDTH)


def token_mixer(h, w_in, b_gate, conv_w, w_conv_out, w_attn_out, lam_vec, subln_w, w_o,
                lam_init, cos, sin):
    b, s = h.shape[0], h.shape[1]
    z = h @ w_in
    c0 = CONV_WIDTH
    q0 = 3 * c0
    idx = [c0, 2 * c0, q0, q0 + QK_WIDTH, q0 + 2 * QK_WIDTH, q0 + 2 * QK_WIDTH + ATTN_WIDTH]
    bg, cg, hc, q, k, v, gl = jnp.split(z, idx, axis=-1)
    y_conv = (bg * short_conv(cg * hc, conv_w)) @ w_conv_out
    q = apply_partial_rope(q.reshape(b, s, N_DIFF_HEADS, 2, HEAD_DIM), cos, sin)
    k = apply_partial_rope(k.reshape(b, s, N_DIFF_HEADS, 2, HEAD_DIM), cos, sin)
    v = v.reshape(b, s, N_DIFF_HEADS, V_HEAD_DIM)
    lv = lam_vec.astype(jnp.float32)
    lam = jnp.exp(jnp.sum(lv[0] * lv[1])) - jnp.exp(jnp.sum(lv[2] * lv[3])) + lam_init
    y_attn = diff_attention(q, k, v, lam, lam_init, subln_w) @ w_attn_out
    g_conv, g_attn = jnp.split(jax.nn.sigmoid(gl + b_gate), 2, axis=-1)
    return (g_conv * y_conv + g_attn * y_attn) @ w_o


def setup_inputs(seed: int = 0) -> dict:
    key = jax.random.key(seed)
    ks = jax.random.split(key, 14)
    nrm = jax.random.normal
    D = D_MODEL
    return {
        "x": nrm(ks[0], (BATCH, SEQ, D), jnp.float32),
        "w_in": nrm(ks[1], (DEPTH, D, IN_WIDTH), jnp.float32) * D ** -0.5,
        "b_gate": nrm(ks[2], (DEPTH, N_BRANCHES * D), jnp.float32) * 0.01,
        "conv_w": nrm(ks[3], (DEPTH, CONV_K, CONV_WIDTH), jnp.float32) * CONV_K ** -0.5,
        "w_conv_out": nrm(ks[4], (DEPTH, CONV_WIDTH, D), jnp.float32) * CONV_WIDTH ** -0.5,
        "w_attn_out": nrm(ks[5], (DEPTH, ATTN_WIDTH, D), jnp.float32) * ATTN_WIDTH ** -0.5,
        "lam_vec": nrm(ks[6], (DEPTH, 4, HEAD_DIM), jnp.float32) * 0.1,
        "subln_w": 1.0 + 0.02 * nrm(ks[7], (DEPTH, V_HEAD_DIM), jnp.float32),
        "w_o": nrm(ks[8], (DEPTH, D, D), jnp.float32) * D ** -0.5,
        "ffn1_w13": nrm(ks[9], (DEPTH, D, 2 * D_FF), jnp.float32) * D ** -0.5,
        "ffn1_w2": nrm(ks[10], (DEPTH, D_FF, D), jnp.float32) * D_FF ** -0.5,
        "ffn2_w13": nrm(ks[11], (DEPTH, D, 2 * D_FF), jnp.float32) * D ** -0.5,
        "ffn2_w2": nrm(ks[12], (DEPTH, D_FF, D), jnp.float32) * D_FF ** -0.5,
        "norm_w": 1.0 + 0.02 * nrm(ks[13], (DEPTH, 6, D), jnp.float32),
    }


def reference(x, w_in, b_gate, conv_w, w_conv_out, w_attn_out, lam_vec, subln_w, w_o,
              ffn1_w13, ffn1_w2, ffn2_w13, ffn2_w2, norm_w):
    cos, sin = rope_tables(x.shape[1])
    for l in range(DEPTH):
        nw = norm_w[l]
        lam_init = 0.8 - 0.6 * math.exp(-0.3 * l)
        x = x + 0.5 * rmsnorm(swiglu(rmsnorm(x, nw[0]), ffn1_w13[l], ffn1_w2[l]), nw[1])
        m = token_mixer(rmsnorm(x, nw[2]), w_in[l], b_gate[l], conv_w[l], w_conv_out[l],
                        w_attn_out[l], lam_vec[l], subln_w[l], w_o[l], lam_init, cos, sin)
        x = x + rmsnorm(m, nw[3])
        x = x + 0.5 * rmsnorm(swiglu(rmsnorm(x, nw[4]), ffn2_w13[l], ffn2_w2[l]), nw[5])
    return x
```

```cpp
#include <hip/hip_runtime.h>
#include <hip/hip_cooperative_groups.h>
#include <cstdio>
namespace cg = cooperative_groups;
__device__ __forceinline__ int opaque_tid() { int t = threadIdx.x; asm volatile("" : "+v"(t)); return t; }
namespace pg8 {
#define PG8_LAS __attribute__((address_space(3)))
typedef unsigned short bf16_t;
typedef short bf16x8 __attribute__((ext_vector_type(8)));
typedef float f32x4 __attribute__((ext_vector_type(4)));
typedef unsigned u32x4 __attribute__((ext_vector_type(4)));
constexpr int BM = 256, BK = 64, HALF = 128, HTB = HALF * BK * 2  , STAGE_BYTES = 8 * HTB, NXCD = 8, WGM = 8;

__host__ __device__ __forceinline__ int lds_byte(int r, int c) { const int st = (r >> 4) * 2 + (c >> 5), rr = r & 15, cc = c & 31, ob = rr * 64 + cc * 2; return st * 1024 + (ob ^ (((ob >> 9) & 1) << 5)); }
__host__ __device__ __forceinline__ void stage_rc(int b, int& R, int& C) { const int st = b / 1024, sb = b % 1024, swz = sb ^ (((sb >> 9) & 1) << 5); R = (st >> 1) * 16 + swz / 64; C = (st & 1) * 32 + (swz % 64) / 2; }
__host__ __device__ __forceinline__ int perm32(int rho) { const int n = rho >> 4, i = rho & 15; return 8 * (i >> 2) + 4 * n + (i & 3); }

struct Unit { int pm, pn; };
struct Gemm { const bf16_t* A; const bf16_t* Bt; int M, N, K; };

struct StaticOrder {
    int nM, nN, nwg, G, c;
    __host__ __device__ void init(int M, int N, int G_, int c_) { nM = M / BM; nN = N / BM; nwg = nM * nN; G = G_; c = c_; }
    __host__ __device__ bool next(int i, Unit& u) const {
        const long L = (long)i * G + c; if (L >= nwg) return false;
        int wgid = (int)L; { const int q = nwg / NXCD, r = nwg % NXCD, xcd = wgid % NXCD, off = wgid / NXCD; wgid = (xcd < r ? xcd * (q + 1) : r * (q + 1) + (xcd - r) * q) + off; }
        const int nig = WGM * nN, gid = wgid / nig, fm = gid * WGM, gsz = (nM - fm) < WGM ? (nM - fm) : WGM;
        u.pm = fm + ((wgid % nig) % gsz); u.pn = (wgid % nig) / gsz; return true;
    }
    __device__ __forceinline__ void a_ready(const Unit&) const {}
    __device__ __forceinline__ void done(const Unit&) const {}
};
template <class Epi, class Sched, bool STAMP = false>
__device__ __forceinline__ void gemm_phase(PG8_LAS unsigned char* lds, const Gemm g, const Sched& S, const Epi& E, unsigned long long* stamps) {
    const int tid = opaque_tid(), wid = __builtin_amdgcn_readfirstlane(tid >> 6), lane = tid & 63, wr = wid >> 2, wc = wid & 3, fr = lane & 15, fq = lane >> 4;
    const int K = g.K, nt = K / BK;
    int ts_lo = 0, ts_hi = 0, nts = 0; const unsigned long long rt_entry = STAMP ? (unsigned long long)wall_clock64() : 0ull;
#define PG8_STAMP() do { if (STAMP && wid == 0 && nts < 64) { const unsigned long long _c = (unsigned long long)clock64(); \
        ts_lo = (lane == nts) ? (int)(unsigned)_c : ts_lo; ts_hi = (lane == nts) ? (int)(unsigned)(_c >> 32) : ts_hi; ++nts; } } while (0)
    PG8_STAMP();
    unsigned voffA[2], voffB[2];
#pragma unroll
    for (int i = 0; i < 2; ++i) { int R, C; stage_rc(tid * 16 + i * 8192, R, C); const int Rb = Epi::PERM ? ((R & ~31) + perm32(R & 31)) : R;
        voffA[i] = (unsigned)(R * K + C) * 2u; voffB[i] = (unsigned)(Rb * K + C) * 2u; }
    const size_t kstep = (size_t)(BK * 2);
    const size_t hstep = (size_t)HALF * K * 2;
    const size_t tstep = 2 * hstep;
    const unsigned ldsw = (unsigned)wid * 1024u;
    const int aoff = lds_byte(wr * 64 + fr, fq * 8), boff = lds_byte(wc * 32 + fr, fq * 8);
#define PG8_SA(b, h) (((b) * 2 + (h)) * HTB)
#define PG8_SB(b, h) ((4 + (b) * 2 + (h)) * HTB)
#define PG8_STAGE(bufoff, gbase, voff) do { _Pragma("unroll") for (int _i = 0; _i < 2; ++_i) \
        __builtin_amdgcn_global_load_lds((const unsigned*)((const char*)(gbase) + (voff)[_i]), (PG8_LAS unsigned*)(lds + (bufoff) + ldsw + _i * 8192), 16, 0, 0); } while (0)
#define PG8_LDA(dst, b, h) do { _Pragma("unroll") for (int m = 0; m < 4; ++m) _Pragma("unroll") for (int k = 0; k < 2; ++k) dst[m][k] = *(const PG8_LAS bf16x8*)(lds + PG8_SA(b, h) + aoff + m * 2048 + k * 1024); } while (0)
#define PG8_LDB(dst, b, h) do { _Pragma("unroll") for (int n = 0; n < 2; ++n) _Pragma("unroll") for (int k = 0; k < 2; ++k) dst[n][k] = *(const PG8_LAS bf16x8*)(lds + PG8_SB(b, h) + boff + n * 2048 + k * 1024); } while (0)
#define PG8_MMA(ai, bj, At, Bt) do { __builtin_amdgcn_s_setprio(1); _Pragma("unroll") for (int m = 0; m < 4; ++m) _Pragma("unroll") for (int n = 0; n < 2; ++n) _Pragma("unroll") for (int k = 0; k < 2; ++k) \
        acc[ai][bj][m][n] = __builtin_amdgcn_mfma_f32_16x16x32_bf16(Bt[n][k], At[m][k], acc[ai][bj][m][n], 0, 0, 0); __builtin_amdgcn_s_setprio(0); } while (0)
#define PG8_WAIT_V(n) asm volatile("s_waitcnt vmcnt(" #n ")" ::: "memory")
#define PG8_WAIT_L(n) asm volatile("s_waitcnt lgkmcnt(" #n ")" ::: "memory")
#define PG8_BAR __builtin_amdgcn_s_barrier()
#define PG8_SCHED __builtin_amdgcn_sched_barrier(0)
    Unit cur, nxt; int ui = 0;
    if (!S.next(0, cur)) return;
    f32x4 acc[2][2][4][2];
#pragma unroll
    for (int a = 0; a < 2; ++a)
#pragma unroll
        for (int b = 0; b < 2; ++b)
#pragma unroll
            for (int m = 0; m < 4; ++m)
#pragma unroll
                for (int n = 0; n < 2; ++n) acc[a][b][m][n] = (f32x4){0.f, 0.f, 0.f, 0.f};
    bf16x8 At[4][2], B0[2][2], B1[2][2];
    const char* cA = (const char*)g.A + (size_t)cur.pm * tstep; const char* cB = (const char*)g.Bt + (size_t)cur.pn * tstep;
    S.a_ready(cur);
    PG8_STAGE(PG8_SB(0, 0), cB, voffB); PG8_STAGE(PG8_SA(0, 0), cA, voffA); PG8_STAGE(PG8_SB(0, 1), cB + hstep, voffB); PG8_STAGE(PG8_SA(0, 1), cA + hstep, voffA);
    if (wr == 1) PG8_BAR;
    PG8_WAIT_V(4); PG8_BAR;
    PG8_STAGE(PG8_SB(1, 0), cB + kstep, voffB); PG8_STAGE(PG8_SA(1, 0), cA + kstep, voffA); PG8_STAGE(PG8_SB(1, 1), cB + hstep + kstep, voffB);
    PG8_WAIT_V(6); PG8_BAR;
    PG8_STAMP();
    for (;;) {
        const bool has_next = S.next(ui + 1, nxt);
        const char* nA = has_next ? (const char*)g.A + (size_t)nxt.pm * tstep : cA; const char* nB = has_next ? (const char*)g.Bt + (size_t)nxt.pn * tstep : cB;
        for (int t = 0; t < nt; t += 2) {
            const bool last = (t == nt - 2);
            const char* a1 = cA + (size_t)(t + 1) * kstep;
            const char* a2 = last ? nA : cA + (size_t)(t + 2) * kstep; const char* b2 = last ? nB : cB + (size_t)(t + 2) * kstep;
            const char* a3 = a2 + kstep; const char* b3 = b2 + kstep;
            if (last && has_next) S.a_ready(nxt);
            PG8_LDB(B0, 0, 0); PG8_SCHED; PG8_LDA(At, 0, 0); PG8_STAGE(PG8_SA(1, 1), a1 + hstep, voffA);
            PG8_WAIT_L(8); PG8_BAR; PG8_WAIT_L(0); PG8_MMA(0, 0, At, B0); PG8_BAR; PG8_SCHED;
            PG8_LDB(B1, 0, 1); PG8_STAGE(PG8_SB(0, 0), b2, voffB);
            PG8_BAR; PG8_WAIT_L(0); PG8_MMA(0, 1, At, B1); PG8_BAR;
            PG8_LDA(At, 0, 1); PG8_STAGE(PG8_SA(0, 0), a2, voffA);
            PG8_BAR; PG8_WAIT_L(0); PG8_MMA(1, 0, At, B0); PG8_BAR; PG8_SCHED;
            PG8_STAGE(PG8_SB(0, 1), b2 + hstep, voffB);
            PG8_WAIT_V(6); PG8_BAR; PG8_MMA(1, 1, At, B1); PG8_BAR;
            PG8_LDB(B0, 1, 0); PG8_SCHED; PG8_LDA(At, 1, 0); PG8_STAGE(PG8_SA(0, 1), a2 + hstep, voffA);
            PG8_WAIT_L(8); PG8_BAR; PG8_WAIT_L(0); PG8_MMA(0, 0, At, B0); PG8_BAR; PG8_SCHED;
            PG8_LDB(B1, 1, 1); PG8_STAGE(PG8_SB(1, 0), b3, voffB);
            PG8_BAR; PG8_WAIT_L(0); PG8_MMA(0, 1, At, B1); PG8_BAR;
            PG8_LDA(At, 1, 1); PG8_STAGE(PG8_SA(1, 0), a3, voffA);
            PG8_BAR; PG8_WAIT_L(0); PG8_MMA(1, 0, At, B0); PG8_BAR; PG8_SCHED;
            PG8_STAGE(PG8_SB(1, 1), b3 + hstep, voffB);
            PG8_WAIT_V(6); PG8_BAR; PG8_MMA(1, 1, At, B1); PG8_BAR;
        }
        PG8_STAMP();
        if constexpr (!Epi::AFTER_DRAIN) { E(acc, cur, wr, wc, fr, fq); S.done(cur); }
        PG8_STAMP();
        if (!has_next) break;
#pragma unroll
        for (int a = 0; a < 2; ++a)
#pragma unroll
            for (int b = 0; b < 2; ++b)
#pragma unroll
                for (int m = 0; m < 4; ++m)
#pragma unroll
                    for (int n = 0; n < 2; ++n) acc[a][b][m][n] = (f32x4){0.f, 0.f, 0.f, 0.f};
        cur = nxt; cA = nA; cB = nB; ++ui;
    }
    PG8_WAIT_V(0);
    if (wr == 0) PG8_BAR;
    PG8_BAR;
    if constexpr (Epi::AFTER_DRAIN) { E.fused(acc, cur, wr, wc, fr, fq, lds, wid, lane); S.done(cur); }
    PG8_STAMP();
    if (STAMP && wid == 0) { stamps[lane] = lane < nts ? (((unsigned long long)(unsigned)ts_hi << 32) | (unsigned)ts_lo) : 0ull;
        if (lane == 62) stamps[62] = rt_entry; if (lane == 63) stamps[63] = (unsigned long long)wall_clock64(); }
#undef PG8_STAMP
#undef PG8_SA
#undef PG8_SB
#undef PG8_STAGE
#undef PG8_LDA
#undef PG8_LDB
#undef PG8_MMA
#undef PG8_WAIT_V
#undef PG8_WAIT_L
#undef PG8_BAR
#undef PG8_SCHED
}
typedef float f32x2 __attribute__((ext_vector_type(2)));
typedef __bf16 bf2_t __attribute__((ext_vector_type(2)));
__device__ __forceinline__ unsigned pk_bf16(float a, float b) { f32x2 v = {a, b}; bf2_t r = __builtin_convertvector(v, bf2_t); return __builtin_bit_cast(unsigned, r); }
__device__ __forceinline__ float bf_lo(unsigned w) { return __uint_as_float(w << 16); }
__device__ __forceinline__ float bf_hi(unsigned w) { return __uint_as_float(w & 0xffff0000u); }
__device__ __forceinline__ float sigmoidf_(float x) { return __builtin_amdgcn_rcpf(1.0f + __builtin_amdgcn_exp2f(-1.44269504f * x)); }

struct EpiF32 {
    static constexpr bool PERM = false, AFTER_DRAIN = false;
    float* C; int ldc;
    __device__ __forceinline__ void operator()(const f32x4 (&acc)[2][2][4][2], const Unit& u, int wr, int wc, int fr, int fq) const {
        const int row0 = u.pm * BM + wr * 64 + fr, col0 = u.pn * BM + wc * 32 + 4 * fq;
#pragma unroll
        for (int ai = 0; ai < 2; ++ai)
#pragma unroll
            for (int m = 0; m < 4; ++m) { float* rowp = C + (size_t)(row0 + ai * HALF + m * 16) * ldc + col0;
#pragma unroll
                for (int bj = 0; bj < 2; ++bj)
#pragma unroll
                    for (int n = 0; n < 2; ++n) *(f32x4*)(rowp + bj * HALF + n * 16) = acc[ai][bj][m][n]; }
    }
};
struct EpiSwiglu {
    static constexpr bool PERM = true, AFTER_DRAIN = false;
    bf16_t* O; int ldc;
    __device__ __forceinline__ void operator()(const f32x4 (&acc)[2][2][4][2], const Unit& u, int wr, int wc, int fr, int fq) const {
        const int row0 = u.pm * BM + wr * 64 + fr, col0 = u.pn * HALF + wc * 32 + 8 * fq;
#pragma unroll
        for (int ai = 0; ai < 2; ++ai)
#pragma unroll
            for (int m = 0; m < 4; ++m) { bf16_t* rowp = O + (size_t)(row0 + ai * HALF + m * 16) * ldc + col0;
                float v[8];
#pragma unroll
                for (int n = 0; n < 2; ++n)
#pragma unroll
                    for (int j = 0; j < 4; ++j) { const float g = acc[ai][0][m][n][j], up = acc[ai][1][m][n][j]; v[n * 4 + j] = g * sigmoidf_(g) * up; }
                u32x4 w; w.x = pk_bf16(v[0], v[1]); w.y = pk_bf16(v[2], v[3]); w.z = pk_bf16(v[4], v[5]); w.w = pk_bf16(v[6], v[7]);
                *(u32x4*)rowp = w; }
    }
};
struct EpiBf16 {
    static constexpr bool PERM = true, AFTER_DRAIN = false;
    bf16_t* O; int ldc; int split_tiles; bf16_t* O2; int rope_tiles; const float* cs; const float* sn;
    __device__ __forceinline__ void operator()(const f32x4 (&acc)[2][2][4][2], const Unit& u, int wr, int wc, int fr, int fq) const {
        const int row0 = u.pm * BM + wr * 64 + fr; int pn = u.pn; bf16_t* base = O;
        if (split_tiles && pn >= split_tiles) { base = O2; pn -= split_tiles; }
        const int col0 = pn * BM + wc * 32 + 8 * fq;
        const bool rope = (u.pn < rope_tiles) && ((wc & 1) == 0);
#pragma unroll
        for (int ai = 0; ai < 2; ++ai)
#pragma unroll
            for (int m = 0; m < 4; ++m) { const int row = row0 + ai * HALF + m * 16; bf16_t* rowp = base + (size_t)row * ldc + col0;
                f32x4 c0 = {1.f, 1.f, 1.f, 1.f}, c1 = c0, s0 = {0.f, 0.f, 0.f, 0.f}, s1 = s0;
                if (rope) { const int pos = row & 2047; c0 = *(const f32x4*)(cs + pos * 8); c1 = *(const f32x4*)(cs + pos * 8 + 4); s0 = *(const f32x4*)(sn + pos * 8); s1 = *(const f32x4*)(sn + pos * 8 + 4);
                    if (fq == 0) { s0 = -s0; s1 = -s1; } if (fq >= 2) { c0 = (f32x4){1.f, 1.f, 1.f, 1.f}; c1 = c0; s0 = (f32x4){0.f, 0.f, 0.f, 0.f}; s1 = s0; } }
#pragma unroll
                for (int bj = 0; bj < 2; ++bj) { f32x4 v0 = acc[ai][bj][m][0], v1 = acc[ai][bj][m][1];
                    if (rope) { f32x4 p0, p1;
#pragma unroll
                        for (int j = 0; j < 4; ++j) { p0[j] = __shfl_xor(v0[j], 16); p1[j] = __shfl_xor(v1[j], 16); }
                        v0 = v0 * c0 + p0 * s0; v1 = v1 * c1 + p1 * s1; }
                    u32x4 w; w.x = pk_bf16(v0[0], v0[1]); w.y = pk_bf16(v0[2], v0[3]); w.z = pk_bf16(v1[0], v1[1]); w.w = pk_bf16(v1[2], v1[3]);
                    *(u32x4*)(rowp + bj * HALF) = w; } }
    }
};
template <int PASS> struct EpiGate {
    static constexpr bool PERM = true, AFTER_DRAIN = false;
    const bf16_t* gl; int ldg; const float* bg; float* m1; bf16_t* mb; int ldc;
    __device__ __forceinline__ void operator()(const f32x4 (&acc)[2][2][4][2], const Unit& u, int wr, int wc, int fr, int fq) const {
        const int row0 = u.pm * BM + wr * 64 + fr, col0 = u.pn * BM + wc * 32 + 8 * fq;
#pragma unroll
        for (int bj = 0; bj < 2; ++bj) { const int col = col0 + bj * HALF;
            const f32x4 b0 = *(const f32x4*)(bg + col), b1 = *(const f32x4*)(bg + col + 4);
#pragma unroll
            for (int ai = 0; ai < 2; ++ai)
#pragma unroll
                for (int m = 0; m < 4; ++m) { const size_t row = (size_t)(row0 + ai * HALF + m * 16);
                    const u32x4 gw = *(const u32x4*)(gl + row * ldg + col);
                    f32x4 g0 = {bf_lo(gw.x), bf_hi(gw.x), bf_lo(gw.y), bf_hi(gw.y)}, g1 = {bf_lo(gw.z), bf_hi(gw.z), bf_lo(gw.w), bf_hi(gw.w)};
                    g0 += b0; g1 += b1; f32x4 v0 = acc[ai][bj][m][0], v1 = acc[ai][bj][m][1];
#pragma unroll
                    for (int j = 0; j < 4; ++j) { v0[j] *= sigmoidf_(g0[j]); v1[j] *= sigmoidf_(g1[j]); }
                    float* mp = m1 + row * ldc + col;
                    if (PASS == 1) { *(f32x4*)mp = v0; *(f32x4*)(mp + 4) = v1; }
                    else { v0 += *(const f32x4*)mp; v1 += *(const f32x4*)(mp + 4);
                        u32x4 w; w.x = pk_bf16(v0[0], v0[1]); w.y = pk_bf16(v0[2], v0[3]); w.z = pk_bf16(v1[0], v1[1]); w.w = pk_bf16(v1[2], v1[3]);
                        *(u32x4*)(mb + row * ldc + col) = w; } } }
    }
};
}
#define LAS __attribute__((address_space(3)))
typedef unsigned short bf16_t;
typedef short bf16x8 __attribute__((ext_vector_type(8)));
typedef float f32x4 __attribute__((ext_vector_type(4)));
typedef float f32x16 __attribute__((ext_vector_type(16)));
typedef unsigned u32x4 __attribute__((ext_vector_type(4)));
typedef unsigned u32x2 __attribute__((ext_vector_type(2)));
using pg8::pk_bf16; using pg8::bf_lo; using pg8::bf_hi;

constexpr int MTOK = 16384, DM = 1024, SEQ = 2048, DFF = 2816, NTHR = 512;
constexpr int LDS_BYTES = 131072;
constexpr float EPS = 1e-6f;
constexpr size_t OFF_W13A = 0, OFF_W2A = 11534336, OFF_W13B = 17301504, OFF_W2B = 28835840, OFF_WIN = 34603008, OFF_WCO = 51380224, OFF_WAO = 53477376, OFF_WO = 55574528;
constexpr size_t OFF_HB = 57671680, OFF_TAB = OFF_HB + 33554432, OFF_RB = OFF_TAB + 131072;
constexpr size_t OFF_AB = OFF_RB, OFF_YF1 = OFF_RB + 92274688;
constexpr size_t OFF_BCH = OFF_RB;
constexpr size_t OFF_QK = OFF_RB, OFF_VT = OFF_RB + 67108864, OFF_GL = OFF_RB + 100663296, OFF_CB = OFF_RB + 167772160;
constexpr size_t OFF_M1 = OFF_QK, OFF_MB = OFF_VT, OFF_YF2 = OFF_GL, OFF_OB = OFF_HB;
constexpr size_t WS_NEED = OFF_CB + 33554432;

struct Params {
    const float* x; const float* w_in; const float* b_gate; const float* conv_w; const float* w_conv_out; const float* w_attn_out; const float* lam_vec; const float* subln_w;
    const float* w_o; const float* ffn1_w13; const float* ffn1_w2; const float* ffn2_w13; const float* ffn2_w2; const float* norm_w; float* out; unsigned char* ws;
};

__device__ __forceinline__ void convert_tile(float* T, const float* src, int ld, int src0, int k0, bf16_t* dst, int K, int n0) {
    const int tid = opaque_tid(), col = tid & 63, kr = tid >> 6;
#pragma unroll
    for (int i = 0; i < 8; ++i) { const int k = kr + 8 * i; T[k * 65 + col] = src[(size_t)(k0 + k) * ld + src0 + col]; }
    __syncthreads();
    const int n = tid >> 3, ch = tid & 7; float v[8];
#pragma unroll
    for (int j = 0; j < 8; ++j) v[j] = T[(ch * 8 + j) * 65 + n];
    u32x4 w; w.x = pk_bf16(v[0], v[1]); w.y = pk_bf16(v[2], v[3]); w.z = pk_bf16(v[4], v[5]); w.w = pk_bf16(v[6], v[7]);
    *(u32x4*)(dst + (size_t)(n0 + n) * K + k0 + ch * 8) = w;
    __syncthreads();
}
__device__ void convert_weights(const Params& p, int l, float* T) {
    unsigned char* ws = p.ws;
    for (int t = blockIdx.x; t < 7040; t += gridDim.x) {
        const float* src; bf16_t* dst; int K, ld, mode, tl;
        if (t < 1408)      { tl = t;        src = p.ffn1_w13 + (size_t)l * 1024 * 5632; dst = (bf16_t*)(ws + OFF_W13A); K = 1024; ld = 5632; mode = 1; }
        else if (t < 2112) { tl = t - 1408; src = p.ffn1_w2 + (size_t)l * 2816 * 1024;  dst = (bf16_t*)(ws + OFF_W2A);  K = 2816; ld = 1024; mode = 0; }
        else if (t < 3520) { tl = t - 2112; src = p.ffn2_w13 + (size_t)l * 1024 * 5632; dst = (bf16_t*)(ws + OFF_W13B); K = 1024; ld = 5632; mode = 1; }
        else if (t < 4224) { tl = t - 3520; src = p.ffn2_w2 + (size_t)l * 2816 * 1024;  dst = (bf16_t*)(ws + OFF_W2B);  K = 2816; ld = 1024; mode = 0; }
        else if (t < 6272) { tl = t - 4224; src = p.w_in + (size_t)l * 1024 * 8192;     dst = (bf16_t*)(ws + OFF_WIN);  K = 1024; ld = 8192; mode = 2; }
        else if (t < 6528) { tl = t - 6272; src = p.w_conv_out + (size_t)l * 1048576;   dst = (bf16_t*)(ws + OFF_WCO);  K = 1024; ld = 1024; mode = 0; }
        else if (t < 6784) { tl = t - 6528; src = p.w_attn_out + (size_t)l * 1048576;   dst = (bf16_t*)(ws + OFF_WAO);  K = 1024; ld = 1024; mode = 0; }
        else               { tl = t - 6784; src = p.w_o + (size_t)l * 1048576;          dst = (bf16_t*)(ws + OFF_WO);   K = 1024; ld = 1024; mode = 0; }
        const int KT = K / 64, nb = tl / KT, kb = tl % KT, n0 = nb * 64; int src0 = n0;
        if (mode == 1) { const int pn = n0 >> 8, bj = (n0 >> 7) & 1, jj = n0 & 127; src0 = bj * DFF + pn * 128 + jj; }
        if (mode == 2) { src0 = (n0 < 5120) ? n0 : (n0 < 7168 ? n0 + 1024 : n0 - 2048); }
        convert_tile(T, src, ld, src0, kb * 64, dst, K, n0);
    }
}
__device__ void rope_tables(float* cs, float* sn) {
    for (int i = blockIdx.x * NTHR + opaque_tid(); i < SEQ * 8; i += gridDim.x * NTHR) {
        const int pos = i >> 3, j = i & 7;
        const float inv = (float)pow(500000.0, -(double)j / 8.0);
        const float ang = (float)pos * inv;
        cs[i] = (float)cos((double)ang); sn[i] = (float)sin((double)ang);
    }
}

__device__ __forceinline__ float wave_sum(float v) { v += __shfl_xor(v, 32); v += __shfl_xor(v, 16); v += __shfl_xor(v, 8); v += __shfl_xor(v, 4); v += __shfl_xor(v, 2); v += __shfl_xor(v, 1); return v; }
template <int MODE> __device__ void row_phase(const float* xin, float* x, const float* y, const float* wpost, float scale, const float* wpre, bf16_t* h) {
    const int lane = opaque_tid() & 63, wid = opaque_tid() >> 6;
    for (int row = blockIdx.x * 8 + wid; row < MTOK; row += gridDim.x * 8) {
        f32x4 xv[4];
        if (MODE == 0) {
#pragma unroll
            for (int i = 0; i < 4; ++i) xv[i] = *(const f32x4*)(xin + (size_t)row * DM + i * 256 + lane * 4);
        } else {
            f32x4 yv[4]; float ss = 0.f;
#pragma unroll
            for (int i = 0; i < 4; ++i) { yv[i] = *(const f32x4*)(y + (size_t)row * DM + i * 256 + lane * 4); xv[i] = *(const f32x4*)(x + (size_t)row * DM + i * 256 + lane * 4);
                ss += yv[i][0] * yv[i][0] + yv[i][1] * yv[i][1] + yv[i][2] * yv[i][2] + yv[i][3] * yv[i][3]; }
            ss = wave_sum(ss); const float rs = scale * __builtin_amdgcn_rsqf(ss * (1.0f / DM) + EPS);
#pragma unroll
            for (int i = 0; i < 4; ++i) { const f32x4 w = *(const f32x4*)(wpost + i * 256 + lane * 4); xv[i] += yv[i] * rs * w; }
        }
#pragma unroll
        for (int i = 0; i < 4; ++i) *(f32x4*)(x + (size_t)row * DM + i * 256 + lane * 4) = xv[i];
        if (MODE != 2) {
            float ss = 0.f;
#pragma unroll
            for (int i = 0; i < 4; ++i) ss += xv[i][0] * xv[i][0] + xv[i][1] * xv[i][1] + xv[i][2] * xv[i][2] + xv[i][3] * xv[i][3];
            ss = wave_sum(ss); const float rs = __builtin_amdgcn_rsqf(ss * (1.0f / DM) + EPS);
#pragma unroll
            for (int i = 0; i < 4; ++i) { const f32x4 w = *(const f32x4*)(wpre + i * 256 + lane * 4); const f32x4 v = xv[i] * rs * w;
                u32x2 o; o.x = pk_bf16(v[0], v[1]); o.y = pk_bf16(v[2], v[3]); *(u32x2*)(h + (size_t)row * DM + i * 256 + lane * 4) = o; }
        }
    }
}

__device__ __forceinline__ void ld8(const bf16_t* p, float (&v)[8]) { const u32x4 w = *(const u32x4*)p; v[0] = bf_lo(w.x); v[1] = bf_hi(w.x); v[2] = bf_lo(w.y); v[3] = bf_hi(w.y); v[4] = bf_lo(w.z); v[5] = bf_hi(w.z); v[6] = bf_lo(w.w); v[7] = bf_hi(w.w); }
__device__ void conv_phase(const bf16_t* bch, const float* cw, bf16_t* cb) {
    for (int item = blockIdx.x * NTHR + opaque_tid(); item < 131072; item += gridDim.x * NTHR) {
        const int cgp = item & 127, chunk = item >> 7, c0 = cgp * 8, tok0 = chunk * 16, s0 = tok0 & (SEQ - 1);
        float w0[8], w1[8], w2[8];
#pragma unroll
        for (int j = 0; j < 8; ++j) { w0[j] = cw[c0 + j]; w1[j] = cw[1024 + c0 + j]; w2[j] = cw[2048 + c0 + j]; }
        float prev[8], cur[8], nxt[8], a[8], b[8];
        if (s0 > 0) { ld8(bch + (size_t)(tok0 - 1) * 3072 + 1024 + c0, a); ld8(bch + (size_t)(tok0 - 1) * 3072 + 2048 + c0, b);
#pragma unroll
            for (int j = 0; j < 8; ++j) prev[j] = a[j] * b[j]; }
        else {
#pragma unroll
            for (int j = 0; j < 8; ++j) prev[j] = 0.f; }
        ld8(bch + (size_t)tok0 * 3072 + 1024 + c0, a); ld8(bch + (size_t)tok0 * 3072 + 2048 + c0, b);
#pragma unroll
        for (int j = 0; j < 8; ++j) cur[j] = a[j] * b[j];
        for (int i = 0; i < 16; ++i) {
            const int tok = tok0 + i;
            if (s0 + i + 1 < SEQ) { ld8(bch + (size_t)(tok + 1) * 3072 + 1024 + c0, a); ld8(bch + (size_t)(tok + 1) * 3072 + 2048 + c0, b);
#pragma unroll
                for (int j = 0; j < 8; ++j) nxt[j] = a[j] * b[j]; }
            else {
#pragma unroll
                for (int j = 0; j < 8; ++j) nxt[j] = 0.f; }
            ld8(bch + (size_t)tok * 3072 + c0, a);
            float o[8];
#pragma unroll
            for (int j = 0; j < 8; ++j) { o[j] = a[j] * (w0[j] * prev[j] + w1[j] * cur[j] + w2[j] * nxt[j]); prev[j] = cur[j]; cur[j] = nxt[j]; }
            u32x4 w; w.x = pk_bf16(o[0], o[1]); w.y = pk_bf16(o[2], o[3]); w.z = pk_bf16(o[4], o[5]); w.w = pk_bf16(o[6], o[7]);
            *(u32x4*)(cb + (size_t)tok * DM + c0) = w;
        }
    }
}

__device__ __forceinline__ float fmax3(float a, float b, float c) { return fmaxf(fmaxf(a, b), c); }
__device__ void attn_phase(LAS unsigned char* lds, const bf16_t* qk, const bf16_t* vt, bf16_t* ob, const float* lv, const float* subln, float lam_init) {
    const int tid = opaque_tid(), wid = __builtin_amdgcn_readfirstlane(tid >> 6), lane = tid & 63, r = lane & 31, hf = lane >> 5;
    const int c = wid >> 2, qw = wid & 3;
    float d1 = 0.f, d2 = 0.f;
    for (int i = 0; i < 64; ++i) { d1 += lv[i] * lv[64 + i]; d2 += lv[128 + i] * lv[192 + i]; }
    const float lam = expf(d1) - expf(d2) + lam_init;
    const float C2 = 0.125f * 1.44269504f;
    const int G = gridDim.x, cb = blockIdx.x;
    const int pr = (r & ~12) | ((r & 4) << 1) | ((r & 8) >> 1);
    const int ksw = (pr >> 1) & 7, vsw = (r >> 1) & 7;
    const int srow = tid >> 3, sch = tid & 7;
    const unsigned sdK = (unsigned)(srow * 128 + ((sch ^ ((srow >> 1) & 7)) << 4));
    for (int it = 0;; ++it) {
        const int u = it * G + cb; if (u >= 1024) break;
        int bh, qb;
        if (G == 256) { bh = it * 16 + (cb & 7) * 2 + (cb >> 7); qb = (cb >> 3) & 15; } else { bh = u >> 4; qb = u & 15; }
        const int b = bh >> 3, h = bh & 7;
        const size_t tok0 = (size_t)b * SEQ;
        const size_t qtok = tok0 + qb * 128 + qw * 32 + r;
        const bf16_t* qrow = qk + qtok * 2048 + h * 128 + c * 64 + 8 * hf;
        bf16x8 Qf[4];
#pragma unroll
        for (int kk = 0; kk < 4; ++kk) Qf[kk] = *(const bf16x8*)(qrow + 16 * kk);
        f32x16 O[4];
#pragma unroll
        for (int d = 0; d < 4; ++d)
#pragma unroll
            for (int i = 0; i < 16; ++i) O[d][i] = 0.f;
        float mrun = -1e30f, lrun = 0.f;
        const bf16_t* kg = qk + (tok0 + srow) * 2048 + 1024 + h * 128 + sch * 8;
        const bf16_t* vg = vt + (size_t)(h * 128 + srow) * MTOK + tok0 + sch * 8;
        u32x4 st[4];
#define ATT_LOAD(t) do { st[0] = *(const u32x4*)(kg + (size_t)(t) * 64 * 2048); st[1] = *(const u32x4*)(kg + (size_t)(t) * 64 * 2048 + 64); \
                         st[2] = *(const u32x4*)(vg + (t) * 64); st[3] = *(const u32x4*)(vg + (t) * 64 + (size_t)64 * MTOK); } while (0)
#define ATT_STORE(buf) do { LAS unsigned char* bs = lds + (buf) * 32768; *(LAS u32x4*)(bs + sdK) = st[0]; *(LAS u32x4*)(bs + 8192 + sdK) = st[1]; \
                         *(LAS u32x4*)(bs + 16384 + sdK) = st[2]; *(LAS u32x4*)(bs + 16384 + 8192 + sdK) = st[3]; } while (0)
        ATT_LOAD(0); ATT_STORE(0);
        __syncthreads();
        for (int t = 0; t < 32; ++t) {
            if (t < 31) ATT_LOAD(t + 1);
            const LAS unsigned char* bb = lds + (t & 1) * 32768;
            f32x16 S0, S1;
#pragma unroll
            for (int i = 0; i < 16; ++i) { S0[i] = 0.f; S1[i] = 0.f; }
            const LAS unsigned char* kb_ = bb + c * 8192 + pr * 128;
#pragma unroll
            for (int kk = 0; kk < 4; ++kk) {
                const int off = ((2 * kk + hf) ^ ksw) << 4;
                const bf16x8 K0 = *(const LAS bf16x8*)(kb_ + off), K1 = *(const LAS bf16x8*)(kb_ + 32 * 128 + off);
                S0 = __builtin_amdgcn_mfma_f32_32x32x16_bf16(K0, Qf[kk], S0, 0, 0, 0);
                S1 = __builtin_amdgcn_mfma_f32_32x32x16_bf16(K1, Qf[kk], S1, 0, 0, 0);
            }
            float tm = fmaxf(S0[0], S1[0]);
#pragma unroll
            for (int i = 1; i < 16; ++i) tm = fmax3(tm, S0[i], S1[i]);
            tm = fmaxf(tm, __shfl_xor(tm, 32));
            const float mn = fmaxf(mrun, tm), alpha = __builtin_amdgcn_exp2f((mrun - mn) * C2), mc = mn * C2;
            mrun = mn;
            float rs = 0.f;
#pragma unroll
            for (int i = 0; i < 16; ++i) { S0[i] = __builtin_amdgcn_exp2f(S0[i] * C2 - mc); S1[i] = __builtin_amdgcn_exp2f(S1[i] * C2 - mc); rs += S0[i] + S1[i]; }
            lrun = lrun * alpha + rs;
            if (__builtin_amdgcn_ballot_w64(alpha != 1.0f) != 0ull) {
#pragma unroll
                for (int d = 0; d < 4; ++d)
#pragma unroll
                    for (int i = 0; i < 16; ++i) O[d][i] *= alpha;
            }
            bf16x8 P[2][2];
#pragma unroll
            for (int s = 0; s < 2; ++s) {
                u32x4 w0, w1;
                w0.x = pk_bf16(S0[8 * s + 0], S0[8 * s + 1]); w0.y = pk_bf16(S0[8 * s + 2], S0[8 * s + 3]); w0.z = pk_bf16(S0[8 * s + 4], S0[8 * s + 5]); w0.w = pk_bf16(S0[8 * s + 6], S0[8 * s + 7]);
                w1.x = pk_bf16(S1[8 * s + 0], S1[8 * s + 1]); w1.y = pk_bf16(S1[8 * s + 2], S1[8 * s + 3]); w1.z = pk_bf16(S1[8 * s + 4], S1[8 * s + 5]); w1.w = pk_bf16(S1[8 * s + 6], S1[8 * s + 7]);
                P[0][s] = __builtin_bit_cast(bf16x8, w0); P[1][s] = __builtin_bit_cast(bf16x8, w1);
            }
            const LAS unsigned char* vb_ = bb + 16384 + r * 128;
#pragma unroll
            for (int d = 0; d < 4; ++d)
#pragma unroll
                for (int kb = 0; kb < 2; ++kb)
#pragma unroll
                    for (int s = 0; s < 2; ++s) {
                        const bf16x8 V = *(const LAS bf16x8*)(vb_ + d * 32 * 128 + (((4 * kb + 2 * s + hf) ^ vsw) << 4));
                        O[d] = __builtin_amdgcn_mfma_f32_32x32x16_bf16(V, P[kb][s], O[d], 0, 0, 0);
                    }
            if (t < 31) ATT_STORE((t + 1) & 1);
            __syncthreads();
        }
#undef ATT_LOAD
#undef ATT_STORE
        const float lt = lrun + __shfl_xor(lrun, 32);
        LAS float* X = (LAS float*)lds + qw * 4096 + lane;
        if (c == 1) { const float sc = lam / lt;
#pragma unroll
            for (int d = 0; d < 4; ++d)
#pragma unroll
                for (int i = 0; i < 16; ++i) X[(d * 16 + i) * 64] = O[d][i] * sc; }
        __syncthreads();
        if (c == 0) { const float sc = 1.0f / lt; float ss = 0.f;
#pragma unroll
            for (int d = 0; d < 4; ++d)
#pragma unroll
                for (int i = 0; i < 16; ++i) { const float o = O[d][i] * sc - X[(d * 16 + i) * 64]; O[d][i] = o; ss += o * o; }
            ss += __shfl_xor(ss, 32);
            const float rms = __builtin_amdgcn_rsqf(ss * (1.0f / 128.0f) + EPS) * (1.0f - lam_init);
            bf16_t* orow = ob + qtok * DM + h * 128 + 4 * hf;
#pragma unroll
            for (int d = 0; d < 4; ++d)
#pragma unroll
                for (int g = 0; g < 4; ++g) { const int dv = 32 * d + 8 * g;
                    const f32x4 w = *(const f32x4*)(subln + dv + 4 * hf);
                    u32x2 o; o.x = pk_bf16(O[d][4 * g] * rms * w[0], O[d][4 * g + 1] * rms * w[1]); o.y = pk_bf16(O[d][4 * g + 2] * rms * w[2], O[d][4 * g + 3] * rms * w[3]);
                    *(u32x2*)(orow + dv) = o; } }
        __syncthreads();
    }
}
template <class Epi> __device__ __forceinline__ void run_gemm(LAS unsigned char* lds, const bf16_t* A, const bf16_t* Bt, int M, int N, int K, const Epi& E) {
    pg8::Gemm g{A, Bt, M, N, K}; pg8::StaticOrder S; S.init(M, N, (int)gridDim.x, (int)blockIdx.x);
    pg8::gemm_phase<Epi, pg8::StaticOrder, false>(lds, g, S, E, nullptr);
}

__global__ void __launch_bounds__(NTHR) fwd_megakernel(Params p) {
    extern __shared__ __attribute__((aligned(16))) unsigned char smem[];
    cg::grid_group grid = cg::this_grid();
    LAS unsigned char* lds = (LAS unsigned char*)smem;
    unsigned char* ws = p.ws;
    bf16_t* W13A = (bf16_t*)(ws + OFF_W13A); bf16_t* W2A = (bf16_t*)(ws + OFF_W2A); bf16_t* W13B = (bf16_t*)(ws + OFF_W13B); bf16_t* W2B = (bf16_t*)(ws + OFF_W2B);
    bf16_t* WIN = (bf16_t*)(ws + OFF_WIN); bf16_t* WCO = (bf16_t*)(ws + OFF_WCO); bf16_t* WAO = (bf16_t*)(ws + OFF_WAO); bf16_t* WO = (bf16_t*)(ws + OFF_WO);
    bf16_t* HB = (bf16_t*)(ws + OFF_HB); float* CS = (float*)(ws + OFF_TAB); float* SN = CS + SEQ * 8;
    bf16_t* AB = (bf16_t*)(ws + OFF_AB); float* YF1 = (float*)(ws + OFF_YF1); bf16_t* BCH = (bf16_t*)(ws + OFF_BCH);
    bf16_t* QK = (bf16_t*)(ws + OFF_QK); bf16_t* VT = (bf16_t*)(ws + OFF_VT); bf16_t* GL = (bf16_t*)(ws + OFF_GL); bf16_t* CB = (bf16_t*)(ws + OFF_CB);
    float* M1 = (float*)(ws + OFF_M1); bf16_t* MB = (bf16_t*)(ws + OFF_MB); float* YF2 = (float*)(ws + OFF_YF2); bf16_t* OB = (bf16_t*)(ws + OFF_OB);
    float* X = p.out;

    convert_weights(p, 0, (float*)smem);
    rope_tables(CS, SN);
    row_phase<0>(p.x, X, nullptr, nullptr, 0.f, p.norm_w, HB);
    grid.sync();
    for (int l = 0; l < 2; ++l) {
        const float* nw = p.norm_w + (size_t)l * 6 * DM;
        const float lam_init = 0.8f - 0.6f * expf(-0.3f * (float)l);
        run_gemm(lds, HB, W13A, MTOK, 2 * DFF, DM, pg8::EpiSwiglu{AB, DFF});
        grid.sync();
        run_gemm(lds, AB, W2A, MTOK, DM, DFF, pg8::EpiF32{YF1, DM});
        grid.sync();
        row_phase<1>(nullptr, X, YF1, nw + DM, 0.5f, nw + 2 * DM, HB);
        grid.sync();
        run_gemm(lds, HB, WIN, MTOK, 3072, DM, pg8::EpiBf16{BCH, 3072, 0, nullptr, 0, nullptr, nullptr});
        grid.sync();
        conv_phase(BCH, p.conv_w + (size_t)l * 3 * DM, CB);
        grid.sync();
        run_gemm(lds, HB, WIN + (size_t)3072 * DM, MTOK, 4096, DM, pg8::EpiBf16{QK, 2048, 8, GL, 8, CS, SN});
        run_gemm(lds, WIN + (size_t)7168 * DM, HB, DM, MTOK, DM, pg8::EpiBf16{VT, MTOK, 0, nullptr, 0, nullptr, nullptr});
        grid.sync();
        attn_phase(lds, QK, VT, OB, p.lam_vec + (size_t)l * 256, p.subln_w + (size_t)l * 128, lam_init);
        grid.sync();
        run_gemm(lds, CB, WCO, MTOK, DM, DM, pg8::EpiGate<1>{GL, 2048, p.b_gate + (size_t)l * 2048, M1, MB, DM});
        run_gemm(lds, OB, WAO, MTOK, DM, DM, pg8::EpiGate<2>{GL + 1024, 2048, p.b_gate + (size_t)l * 2048 + 1024, M1, MB, DM});
        grid.sync();
        run_gemm(lds, MB, WO, MTOK, DM, DM, pg8::EpiF32{YF2, DM});
        grid.sync();
        row_phase<1>(nullptr, X, YF2, nw + 3 * DM, 1.0f, nw + 4 * DM, HB);
        grid.sync();
        run_gemm(lds, HB, W13B, MTOK, 2 * DFF, DM, pg8::EpiSwiglu{AB, DFF});
        grid.sync();
        run_gemm(lds, AB, W2B, MTOK, DM, DFF, pg8::EpiF32{YF1, DM});
        grid.sync();
        if (l == 0) { row_phase<1>(nullptr, X, YF1, nw + 5 * DM, 0.5f, nw + 6 * DM, HB); convert_weights(p, 1, (float*)smem); grid.sync(); }
        else row_phase<2>(nullptr, X, YF1, nw + 5 * DM, 0.5f, nullptr, nullptr);
    }
}

extern "C" void kernel_launch(void* const* d_in, const int* in_sizes, int n_in, void* d_out, int out_size, void* d_ws, size_t ws_size, hipStream_t stream) {
    static int grid_blocks = 0;
    if (grid_blocks == 0) {
        if (ws_size < WS_NEED) { fprintf(stderr, "kernel_launch: workspace too small: %zu < %zu\n", ws_size, (size_t)WS_NEED); grid_blocks = -1; return; }
        int dev = 0, cus = 0, per_cu = 0;
        hipGetDevice(&dev);
        hipDeviceGetAttribute(&cus, hipDeviceAttributeMultiprocessorCount, dev);
        if (hipFuncSetAttribute((const void*)fwd_megakernel, hipFuncAttributeMaxDynamicSharedMemorySize, LDS_BYTES) != hipSuccess) { fprintf(stderr, "kernel_launch: hipFuncSetAttribute failed\n"); grid_blocks = -1; return; }
        if (hipOccupancyMaxActiveBlocksPerMultiprocessor(&per_cu, (const void*)fwd_megakernel, NTHR, LDS_BYTES) != hipSuccess || per_cu < 1) { fprintf(stderr, "kernel_launch: occupancy query failed (%d)\n", per_cu); grid_blocks = -1; return; }
        grid_blocks = cus * 1;
        fprintf(stderr, "kernel_launch: cus %d per_cu %d grid %d ws %zu\n", cus, per_cu, grid_blocks, ws_size);
    }
    if (grid_blocks < 0) return;
    Params p{};
    p.x = (const float*)d_in[0]; p.w_in = (const float*)d_in[1]; p.b_gate = (const float*)d_in[2]; p.conv_w = (const float*)d_in[3]; p.w_conv_out = (const float*)d_in[4];
    p.w_attn_out = (const float*)d_in[5]; p.lam_vec = (const float*)d_in[6]; p.subln_w = (const float*)d_in[7]; p.w_o = (const float*)d_in[8];
    p.ffn1_w13 = (const float*)d_in[9]; p.ffn1_w2 = (const float*)d_in[10]; p.ffn2_w13 = (const float*)d_in[11]; p.ffn2_w2 = (const float*)d_in[12]; p.norm_w = (const float*)d_in[13];
    p.out = (float*)d_out; p.ws = (unsigned char*)d_ws;
    void* args[] = {&p};
    hipError_t e = hipLaunchCooperativeKernel((const void*)fwd_megakernel, dim3(grid_blocks), dim3(NTHR), args, LDS_BYTES, stream);
    if (e != hipSuccess) fprintf(stderr, "cooperative launch failed: %s (grid %d)\n", hipGetErrorString(e), grid_blocks);
}
```

```cpp
#include <hip/hip_runtime.h>
#include <hip/hip_cooperative_groups.h>
#include <cstdio>
namespace cg = cooperative_groups;
__device__ __forceinline__ int opaque_tid() { int t = threadIdx.x; asm volatile("" : "+v"(t)); return t; }
namespace pg8 {
#define PG8_LAS __attribute__((address_space(3)))
typedef unsigned short bf16_t;
typedef short bf16x8 __attribute__((ext_vector_type(8)));
typedef float f32x4 __attribute__((ext_vector_type(4)));
typedef unsigned u32x4 __attribute__((ext_vector_type(4)));
constexpr int BM = 256, BK = 64, HALF = 128, HTB = HALF * BK * 2  , STAGE_BYTES = 8 * HTB, NXCD = 8, WGM = 8;

__host__ __device__ __forceinline__ int lds_byte(int r, int c) { const int st = (r >> 4) * 2 + (c >> 5), rr = r & 15, cc = c & 31, ob = rr * 64 + cc * 2; return st * 1024 + (ob ^ (((ob >> 9) & 1) << 5)); }
__host__ __device__ __forceinline__ void stage_rc(int b, int& R, int& C) { const int st = b / 1024, sb = b % 1024, swz = sb ^ (((sb >> 9) & 1) << 5); R = (st >> 1) * 16 + swz / 64; C = (st & 1) * 32 + (swz % 64) / 2; }
__host__ __device__ __forceinline__ int perm32(int rho) { const int n = rho >> 4, i = rho & 15; return 8 * (i >> 2) + 4 * n + (i & 3); }

struct Unit { int pm, pn; };
struct Gemm { const bf16_t* A; const bf16_t* Bt; int M, N, K; };

struct StaticOrder {
    int nM, nN, nwg, G, c;
    __host__ __device__ void init(int M, int N, int G_, int c_) { nM = M / BM; nN = N / BM; nwg = nM * nN; G = G_; c = c_; }
    __host__ __device__ bool next(int i, Unit& u) const {
        const long L = (long)i * G + c; if (L >= nwg) return false;
        int wgid = (int)L; { const int q = nwg / NXCD, r = nwg % NXCD, xcd = wgid % NXCD, off = wgid / NXCD; wgid = (xcd < r ? xcd * (q + 1) : r * (q + 1) + (xcd - r) * q) + off; }
        const int nig = WGM * nN, gid = wgid / nig, fm = gid * WGM, gsz = (nM - fm) < WGM ? (nM - fm) : WGM;
        u.pm = fm + ((wgid % nig) % gsz); u.pn = (wgid % nig) / gsz; return true;
    }
    __device__ __forceinline__ void a_ready(const Unit&) const {}
    __device__ __forceinline__ void done(const Unit&) const {}
};
template <class Epi, class Sched, bool STAMP = false>
__device__ __forceinline__ void gemm_phase(PG8_LAS unsigned char* lds, const Gemm g, const Sched& S, const Epi& E, unsigned long long* stamps) {
    const int tid = opaque_tid(), wid = __builtin_amdgcn_readfirstlane(tid >> 6), lane = tid & 63, wr = wid >> 2, wc = wid & 3, fr = lane & 15, fq = lane >> 4;
    const int K = g.K, nt = K / BK;
    int ts_lo = 0, ts_hi = 0, nts = 0; const unsigned long long rt_entry = STAMP ? (unsigned long long)wall_clock64() : 0ull;
#define PG8_STAMP() do { if (STAMP && wid == 0 && nts < 64) { const unsigned long long _c = (unsigned long long)clock64(); \
        ts_lo = (lane == nts) ? (int)(unsigned)_c : ts_lo; ts_hi = (lane == nts) ? (int)(unsigned)(_c >> 32) : ts_hi; ++nts; } } while (0)
    PG8_STAMP();
    unsigned voffA[2], voffB[2];
#pragma unroll
    for (int i = 0; i < 2; ++i) { int R, C; stage_rc(tid * 16 + i * 8192, R, C); const int Rb = Epi::PERM ? ((R & ~31) + perm32(R & 31)) : R;
        voffA[i] = (unsigned)(R * K + C) * 2u; voffB[i] = (unsigned)(Rb * K + C) * 2u; }
    const size_t kstep = (size_t)(BK * 2);
    const size_t hstep = (size_t)HALF * K * 2;
    const size_t tstep = 2 * hstep;
    const unsigned ldsw = (unsigned)wid * 1024u;
    const int aoff = lds_byte(wr * 64 + fr, fq * 8), boff = lds_byte(wc * 32 + fr, fq * 8);
#define PG8_SA(b, h) (((b) * 2 + (h)) * HTB)
#define PG8_SB(b, h) ((4 + (b) * 2 + (h)) * HTB)
#define PG8_STAGE(bufoff, gbase, voff) do { _Pragma("unroll") for (int _i = 0; _i < 2; ++_i) \
        __builtin_amdgcn_global_load_lds((const unsigned*)((const char*)(gbase) + (voff)[_i]), (PG8_LAS unsigned*)(lds + (bufoff) + ldsw + _i * 8192), 16, 0, 0); } while (0)
#define PG8_LDA(dst, b, h) do { _Pragma("unroll") for (int m = 0; m < 4; ++m) _Pragma("unroll") for (int k = 0; k < 2; ++k) dst[m][k] = *(const PG8_LAS bf16x8*)(lds + PG8_SA(b, h) + aoff + m * 2048 + k * 1024); } while (0)
#define PG8_LDB(dst, b, h) do { _Pragma("unroll") for (int n = 0; n < 2; ++n) _Pragma("unroll") for (int k = 0; k < 2; ++k) dst[n][k] = *(const PG8_LAS bf16x8*)(lds + PG8_SB(b, h) + boff + n * 2048 + k * 1024); } while (0)
#define PG8_MMA(ai, bj, At, Bt) do { __builtin_amdgcn_s_setprio(1); _Pragma("unroll") for (int m = 0; m < 4; ++m) _Pragma("unroll") for (int n = 0; n < 2; ++n) _Pragma("unroll") for (int k = 0; k < 2; ++k) \
        acc[ai][bj][m][n] = __builtin_amdgcn_mfma_f32_16x16x32_bf16(Bt[n][k], At[m][k], acc[ai][bj][m][n], 0, 0, 0); __builtin_amdgcn_s_setprio(0); } while (0)
#define PG8_WAIT_V(n) asm volatile("s_waitcnt vmcnt(" #n ")" ::: "memory")
#define PG8_WAIT_L(n) asm volatile("s_waitcnt lgkmcnt(" #n ")" ::: "memory")
#define PG8_BAR __builtin_amdgcn_s_barrier()
#define PG8_SCHED __builtin_amdgcn_sched_barrier(0)
    Unit cur, nxt; int ui = 0;
    if (!S.next(0, cur)) return;
    f32x4 acc[2][2][4][2];
#pragma unroll
    for (int a = 0; a < 2; ++a)
#pragma unroll
        for (int b = 0; b < 2; ++b)
#pragma unroll
            for (int m = 0; m < 4; ++m)
#pragma unroll
                for (int n = 0; n < 2; ++n) acc[a][b][m][n] = (f32x4){0.f, 0.f, 0.f, 0.f};
    bf16x8 At[4][2], B0[2][2], B1[2][2];
    const char* cA = (const char*)g.A + (size_t)cur.pm * tstep; const char* cB = (const char*)g.Bt + (size_t)cur.pn * tstep;
    S.a_ready(cur);
    PG8_STAGE(PG8_SB(0, 0), cB, voffB); PG8_STAGE(PG8_SA(0, 0), cA, voffA); PG8_STAGE(PG8_SB(0, 1), cB + hstep, voffB); PG8_STAGE(PG8_SA(0, 1), cA + hstep, voffA);
    if (wr == 1) PG8_BAR;
    PG8_WAIT_V(4); PG8_BAR;
    PG8_STAGE(PG8_SB(1, 0), cB + kstep, voffB); PG8_STAGE(PG8_SA(1, 0), cA + kstep, voffA); PG8_STAGE(PG8_SB(1, 1), cB + hstep + kstep, voffB);
    PG8_WAIT_V(6); PG8_BAR;
    PG8_STAMP();
    for (;;) {
        const bool has_next = S.next(ui + 1, nxt);
        const char* nA = has_next ? (const char*)g.A + (size_t)nxt.pm * tstep : cA; const char* nB = has_next ? (const char*)g.Bt + (size_t)nxt.pn * tstep : cB;
        for (int t = 0; t < nt; t += 2) {
            const bool last = (t == nt - 2);
            const char* a1 = cA + (size_t)(t + 1) * kstep;
            const char* a2 = last ? nA : cA + (size_t)(t + 2) * kstep; const char* b2 = last ? nB : cB + (size_t)(t + 2) * kstep;
            const char* a3 = a2 + kstep; const char* b3 = b2 + kstep;
            if (last && has_next) S.a_ready(nxt);
            PG8_LDB(B0, 0, 0); PG8_SCHED; PG8_LDA(At, 0, 0); PG8_STAGE(PG8_SA(1, 1), a1 + hstep, voffA);
            PG8_WAIT_L(8); PG8_BAR; PG8_WAIT_L(0); PG8_MMA(0, 0, At, B0); PG8_BAR; PG8_SCHED;
            PG8_LDB(B1, 0, 1); PG8_STAGE(PG8_SB(0, 0), b2, voffB);
            PG8_BAR; PG8_WAIT_L(0); PG8_MMA(0, 1, At, B1); PG8_BAR;
            PG8_LDA(At, 0, 1); PG8_STAGE(PG8_SA(0, 0), a2, voffA);
            PG8_BAR; PG8_WAIT_L(0); PG8_MMA(1, 0, At, B0); PG8_BAR; PG8_SCHED;
            PG8_STAGE(PG8_SB(0, 1), b2 + hstep, voffB);
            PG8_WAIT_V(6); PG8_BAR; PG8_MMA(1, 1, At, B1); PG8_BAR;
            PG8_LDB(B0, 1, 0); PG8_SCHED; PG8_LDA(At, 1, 0); PG8_STAGE(PG8_SA(0, 1), a2 + hstep, voffA);
            PG8_WAIT_L(8); PG8_BAR; PG8_WAIT_L(0); PG8_MMA(0, 0, At, B0); PG8_BAR; PG8_SCHED;
            PG8_LDB(B1, 1, 1); PG8_STAGE(PG8_SB(1, 0), b3, voffB);
            PG8_BAR; PG8_WAIT_L(0); PG8_MMA(0, 1, At, B1); PG8_BAR;
            PG8_LDA(At, 1, 1); PG8_STAGE(PG8_SA(1, 0), a3, voffA);
            PG8_BAR; PG8_WAIT_L(0); PG8_MMA(1, 0, At, B0); PG8_BAR; PG8_SCHED;
            PG8_STAGE(PG8_SB(1, 1), b3 + hstep, voffB);
            PG8_WAIT_V(6); PG8_BAR; PG8_MMA(1, 1, At, B1); PG8_BAR;
        }
        PG8_STAMP();
        if constexpr (!Epi::AFTER_DRAIN) { E(acc, cur, wr, wc, fr, fq); S.done(cur); }
        PG8_STAMP();
        if (!has_next) break;
#pragma unroll
        for (int a = 0; a < 2; ++a)
#pragma unroll
            for (int b = 0; b < 2; ++b)
#pragma unroll
                for (int m = 0; m < 4; ++m)
#pragma unroll
                    for (int n = 0; n < 2; ++n) acc[a][b][m][n] = (f32x4){0.f, 0.f, 0.f, 0.f};
        cur = nxt; cA = nA; cB = nB; ++ui;
    }
    PG8_WAIT_V(0);
    if (wr == 0) PG8_BAR;
    PG8_BAR;
    if constexpr (Epi::AFTER_DRAIN) { E.fused(acc, cur, wr, wc, fr, fq, lds, wid, lane); S.done(cur); }
    PG8_STAMP();
    if (STAMP && wid == 0) { stamps[lane] = lane < nts ? (((unsigned long long)(unsigned)ts_hi << 32) | (unsigned)ts_lo) : 0ull;
        if (lane == 62) stamps[62] = rt_entry; if (lane == 63) stamps[63] = (unsigned long long)wall_clock64(); }
#undef PG8_STAMP
#undef PG8_SA
#undef PG8_SB
#undef PG8_STAGE
#undef PG8_LDA
#undef PG8_LDB
#undef PG8_MMA
#undef PG8_WAIT_V
#undef PG8_WAIT_L
#undef PG8_BAR
#undef PG8_SCHED
}
typedef float f32x2 __attribute__((ext_vector_type(2)));
typedef unsigned u32x2v __attribute__((ext_vector_type(2)));
typedef __bf16 bf2_t __attribute__((ext_vector_type(2)));
__device__ __forceinline__ unsigned pk_bf16(float a, float b) { f32x2 v = {a, b}; bf2_t r = __builtin_convertvector(v, bf2_t); return __builtin_bit_cast(unsigned, r); }
__device__ __forceinline__ float bf_lo(unsigned w) { return __uint_as_float(w << 16); }
__device__ __forceinline__ float bf_hi(unsigned w) { return __uint_as_float(w & 0xffff0000u); }
__device__ __forceinline__ float sigmoidf_(float x) { return __builtin_amdgcn_rcpf(1.0f + __builtin_amdgcn_exp2f(-1.44269504f * x)); }

struct EpiF32 {
    static constexpr bool PERM = false, AFTER_DRAIN = false;
    float* C; int ldc;
    __device__ __forceinline__ void operator()(const f32x4 (&acc)[2][2][4][2], const Unit& u, int wr, int wc, int fr, int fq) const {
        const int row0 = u.pm * BM + wr * 64 + fr, col0 = u.pn * BM + wc * 32 + 4 * fq;
#pragma unroll
        for (int ai = 0; ai < 2; ++ai)
#pragma unroll
            for (int m = 0; m < 4; ++m) { float* rowp = C + (size_t)(row0 + ai * HALF + m * 16) * ldc + col0;
#pragma unroll
                for (int bj = 0; bj < 2; ++bj)
#pragma unroll
                    for (int n = 0; n < 2; ++n) *(f32x4*)(rowp + bj * HALF + n * 16) = acc[ai][bj][m][n]; }
    }
};
template <bool ACT> struct EpiGlu {
    static constexpr bool PERM = true, AFTER_DRAIN = false;
    bf16_t* O; int ldc;
    __device__ __forceinline__ void operator()(const f32x4 (&acc)[2][2][4][2], const Unit& u, int wr, int wc, int fr, int fq) const {
        const int row0 = u.pm * BM + wr * 64 + fr, col0 = u.pn * HALF + wc * 32 + 8 * fq;
#pragma unroll
        for (int ai = 0; ai < 2; ++ai)
#pragma unroll
            for (int m = 0; m < 4; ++m) { bf16_t* rowp = O + (size_t)(row0 + ai * HALF + m * 16) * ldc + col0;
                float v[8];
#pragma unroll
                for (int n = 0; n < 2; ++n)
#pragma unroll
                    for (int j = 0; j < 4; ++j) { const float g = acc[ai][0][m][n][j], up = acc[ai][1][m][n][j]; v[n * 4 + j] = ACT ? g * sigmoidf_(g) * up : g * up; }
                u32x4 w; w.x = pk_bf16(v[0], v[1]); w.y = pk_bf16(v[2], v[3]); w.z = pk_bf16(v[4], v[5]); w.w = pk_bf16(v[6], v[7]);
                *(u32x4*)rowp = w; }
    }
};
struct EpiBf16 {
    static constexpr bool PERM = true, AFTER_DRAIN = false;
    bf16_t* O; int ldc; int split_tiles; bf16_t* O2; int rope_tiles; const float* cs; const float* sn; int ldc2; int qs_tiles; float qscale;
    __device__ __forceinline__ void operator()(const f32x4 (&acc)[2][2][4][2], const Unit& u, int wr, int wc, int fr, int fq) const {
        const int row0 = u.pm * BM + wr * 64 + fr; int pn = u.pn; bf16_t* base = O; int ld = ldc;
        if (split_tiles && pn >= split_tiles) { base = O2; pn -= split_tiles; ld = ldc2; }
        const int col0 = pn * BM + wc * 32 + 8 * fq;
        const bool rope = (u.pn < rope_tiles) && ((wc & 1) == 0);
#pragma unroll
        for (int ai = 0; ai < 2; ++ai)
#pragma unroll
            for (int m = 0; m < 4; ++m) { const int row = row0 + ai * HALF + m * 16; bf16_t* rowp = base + (size_t)row * ld + col0;
                f32x4 c0 = {1.f, 1.f, 1.f, 1.f}, c1 = c0, s0 = {0.f, 0.f, 0.f, 0.f}, s1 = s0;
                if (rope) { const int pos = row & 2047; c0 = *(const f32x4*)(cs + pos * 8); c1 = *(const f32x4*)(cs + pos * 8 + 4); s0 = *(const f32x4*)(sn + pos * 8); s1 = *(const f32x4*)(sn + pos * 8 + 4);
                    if (fq == 0) { s0 = -s0; s1 = -s1; } if (fq >= 2) { c0 = (f32x4){1.f, 1.f, 1.f, 1.f}; c1 = c0; s0 = (f32x4){0.f, 0.f, 0.f, 0.f}; s1 = s0; } }
#pragma unroll
                for (int bj = 0; bj < 2; ++bj) { f32x4 v0 = acc[ai][bj][m][0], v1 = acc[ai][bj][m][1];
                    if (u.pn < qs_tiles) { v0 *= qscale; v1 *= qscale; }
                    if (rope) { f32x4 p0, p1;
#pragma unroll
                        for (int j = 0; j < 4; ++j) { p0[j] = __shfl_xor(v0[j], 16); p1[j] = __shfl_xor(v1[j], 16); }
                        v0 = v0 * c0 + p0 * s0; v1 = v1 * c1 + p1 * s1; }
                    u32x4 w; w.x = pk_bf16(v0[0], v0[1]); w.y = pk_bf16(v0[2], v0[3]); w.z = pk_bf16(v1[0], v1[1]); w.w = pk_bf16(v1[2], v1[3]);
                    *(u32x4*)(rowp + bj * HALF) = w; } }
    }
};
template <int PASS> struct EpiGate {
    static constexpr bool PERM = true, AFTER_DRAIN = false;
    const bf16_t* gl; int ldg; const float* bg; bf16_t* m1; bf16_t* mb; int ldc;
    __device__ __forceinline__ void operator()(const f32x4 (&acc)[2][2][4][2], const Unit& u, int wr, int wc, int fr, int fq) const {
        const int row0 = u.pm * BM + wr * 64 + fr, col0 = u.pn * BM + wc * 32 + 8 * fq;
#pragma unroll
        for (int bj = 0; bj < 2; ++bj) { const int col = col0 + bj * HALF;
            const f32x4 b0 = *(const f32x4*)(bg + col), b1 = *(const f32x4*)(bg + col + 4);
#pragma unroll
            for (int ai = 0; ai < 2; ++ai)
#pragma unroll
                for (int m = 0; m < 4; ++m) { const size_t row = (size_t)(row0 + ai * HALF + m * 16);
                    const u32x4 gw = *(const u32x4*)(gl + row * ldg + col);
                    f32x4 g0 = {bf_lo(gw.x), bf_hi(gw.x), bf_lo(gw.y), bf_hi(gw.y)}, g1 = {bf_lo(gw.z), bf_hi(gw.z), bf_lo(gw.w), bf_hi(gw.w)};
                    g0 += b0; g1 += b1; f32x4 v0 = acc[ai][bj][m][0], v1 = acc[ai][bj][m][1];
#pragma unroll
                    for (int j = 0; j < 4; ++j) { v0[j] *= sigmoidf_(g0[j]); v1[j] *= sigmoidf_(g1[j]); }
                    bf16_t* mp = m1 + row * ldc + col;
                    if (PASS == 2) { const u32x4 pw = *(const u32x4*)mp;
                        v0 += (f32x4){bf_lo(pw.x), bf_hi(pw.x), bf_lo(pw.y), bf_hi(pw.y)}; v1 += (f32x4){bf_lo(pw.z), bf_hi(pw.z), bf_lo(pw.w), bf_hi(pw.w)}; }
                    u32x4 w; w.x = pk_bf16(v0[0], v0[1]); w.y = pk_bf16(v0[2], v0[3]); w.z = pk_bf16(v1[0], v1[1]); w.w = pk_bf16(v1[2], v1[3]);
                    *(u32x4*)((PASS == 1 ? mp : mb + row * ldc + col)) = w; } }
    }
};
struct EpiNormRes {
    static constexpr bool PERM = false, AFTER_DRAIN = true;
    const float* xin; float* x; const float* wpost; float scale; const float* wpre; bf16_t* h; float* slots; unsigned* cnt; unsigned ex0;
    __device__ __forceinline__ void stats(const f32x4 (&v)[2][2][4][2], const Unit& u, int wr, int wc, int fr, int fq, PG8_LAS unsigned char* lds, int wid, int lane, unsigned ex) const {
        PG8_LAS float* P = (PG8_LAS float*)lds;
        PG8_LAS float* S = (PG8_LAS float*)(lds + 4096);
#pragma unroll
        for (int ai = 0; ai < 2; ++ai)
#pragma unroll
            for (int m = 0; m < 4; ++m) { float s = 0.f;
#pragma unroll
                for (int bj = 0; bj < 2; ++bj)
#pragma unroll
                    for (int n = 0; n < 2; ++n) { const f32x4 t = v[ai][bj][m][n]; s += (t[0] * t[0] + t[1] * t[1]) + (t[2] * t[2] + t[3] * t[3]); }
                s += __shfl_xor(s, 16); s += __shfl_xor(s, 32);
                if (fq == 0) P[(ai * HALF + wr * 64 + m * 16 + fr) * 4 + wc] = s; }
        asm volatile("s_waitcnt lgkmcnt(0)" ::: "memory"); __builtin_amdgcn_s_barrier(); asm volatile("" ::: "memory");
        const int row = wid * 32 + (lane & 31);
        float* slot = slots + ((size_t)(ex & 1u) * 16384 + (size_t)(u.pm * BM + row)) * 4;
        if (lane < 32) { const float tot = (P[row * 4 + 0] + P[row * 4 + 1]) + (P[row * 4 + 2] + P[row * 4 + 3]);
            __hip_atomic_store(slot + u.pn, tot, __ATOMIC_RELAXED, __HIP_MEMORY_SCOPE_AGENT); }
        asm volatile("s_waitcnt vmcnt(0)" ::: "memory");
        if (lane == 0) __hip_atomic_fetch_add(cnt + 64 * u.pm, 1u, __ATOMIC_RELAXED, __HIP_MEMORY_SCOPE_AGENT);
        if (wid == 0) { const unsigned want = 32u * (ex + 1u); unsigned spins = 0;
            while ((unsigned)__builtin_amdgcn_readfirstlane(__hip_atomic_load(cnt + 64 * u.pm, __ATOMIC_RELAXED, __HIP_MEMORY_SCOPE_AGENT)) < want) { __builtin_amdgcn_s_sleep(2); if (++spins > (1u << 22)) break; }
            __builtin_amdgcn_fence(__ATOMIC_ACQUIRE, "agent"); }
        asm volatile("s_waitcnt vmcnt(0) lgkmcnt(0)" ::: "memory"); __builtin_amdgcn_s_barrier(); asm volatile("" ::: "memory");
        if (lane < 32) { float q = 0.f;
#pragma unroll
            for (int t = 0; t < 4; ++t) q += __hip_atomic_load(slot + t, __ATOMIC_RELAXED, __HIP_MEMORY_SCOPE_AGENT);
            S[row] = __builtin_amdgcn_rsqf(q * (1.0f / 1024.0f) + 1e-6f); }
        asm volatile("s_waitcnt vmcnt(0) lgkmcnt(0)" ::: "memory"); __builtin_amdgcn_s_barrier(); asm volatile("" ::: "memory");
    }
    __device__ __forceinline__ void fused(f32x4 (&acc)[2][2][4][2], const Unit& u, int wr, int wc, int fr, int fq, PG8_LAS unsigned char* lds, int wid, int lane) const {
        const PG8_LAS float* S = (const PG8_LAS float*)(lds + 4096);
        const int col0 = u.pn * BM + wc * 32 + 4 * fq;
        stats(acc, u, wr, wc, fr, fq, lds, wid, lane, ex0);
#pragma unroll
        for (int ai = 0; ai < 2; ++ai)
#pragma unroll
            for (int m = 0; m < 4; ++m) { const int r = ai * HALF + wr * 64 + m * 16 + fr; const float rs = S[r] * scale; const size_t off = (size_t)(u.pm * BM + r) * 1024 + col0;
#pragma unroll
                for (int bj = 0; bj < 2; ++bj)
#pragma unroll
                    for (int n = 0; n < 2; ++n) { const f32x4 xv = *(const f32x4*)(xin + off + bj * HALF + n * 16); const f32x4 w = *(const f32x4*)(wpost + col0 + bj * HALF + n * 16);
                        const f32x4 o = xv + acc[ai][bj][m][n] * rs * w; acc[ai][bj][m][n] = o; *(f32x4*)(x + off + bj * HALF + n * 16) = o; }
                asm volatile("" : "+v"(acc[ai][0][m][0]), "+v"(acc[ai][0][m][1]), "+v"(acc[ai][1][m][0]), "+v"(acc[ai][1][m][1]));
                if (m & 1) asm volatile("" ::: "memory"); }
        if (h == nullptr) return;
        stats(acc, u, wr, wc, fr, fq, lds, wid, lane, ex0 + 1u);
#pragma unroll
        for (int ai = 0; ai < 2; ++ai)
#pragma unroll
            for (int m = 0; m < 4; ++m) { const int r = ai * HALF + wr * 64 + m * 16 + fr; const float rs = S[r]; const size_t off = (size_t)(u.pm * BM + r) * 1024 + col0;
#pragma unroll
                for (int bj = 0; bj < 2; ++bj)
#pragma unroll
                    for (int n = 0; n < 2; ++n) { const f32x4 w = *(const f32x4*)(wpre + col0 + bj * HALF + n * 16); const f32x4 o = acc[ai][bj][m][n] * rs * w;
                        u32x2v ov; ov.x = pk_bf16(o[0], o[1]); ov.y = pk_bf16(o[2], o[3]); *(u32x2v*)(h + off + bj * HALF + n * 16) = ov; } }
    }
};
}
#define LAS __attribute__((address_space(3)))
typedef unsigned short bf16_t;
typedef short bf16x8 __attribute__((ext_vector_type(8)));
typedef float f32x4 __attribute__((ext_vector_type(4)));
typedef float f32x16 __attribute__((ext_vector_type(16)));
typedef unsigned u32x4 __attribute__((ext_vector_type(4)));
typedef unsigned u32x2 __attribute__((ext_vector_type(2)));
using pg8::pk_bf16; using pg8::bf_lo; using pg8::bf_hi;

constexpr int MTOK = 16384, DM = 1024, SEQ = 2048, DFF = 2816, NTHR = 512;
constexpr int LDS_BYTES = 131072 + 16;
constexpr float EPS = 1e-6f;
constexpr size_t OFF_W13A = 0, OFF_W2A = 11534336, OFF_W13B = 17301504, OFF_W2B = 28835840, OFF_WIN = 34603008, OFF_WCO = 51380224, OFF_WAO = 53477376, OFF_WO = 55574528;
constexpr size_t OFF_HB = 57671680, OFF_TAB = OFF_HB + 33554432, OFF_RB = OFF_TAB + 131072;
constexpr size_t OFF_AB = OFF_RB, OFF_YF1 = OFF_RB + 92274688;
constexpr size_t OFF_TCH = OFF_RB, OFF_BB = OFF_RB + 33554432;
constexpr int QK_LD = 2048 + 128, VT_LD = 16384 + 128;
constexpr size_t OFF_QK = OFF_RB, OFF_VT = OFF_QK + (size_t)MTOK * QK_LD * 2, OFF_GL = OFF_VT + (size_t)1024 * VT_LD * 2, OFF_CB = OFF_GL + 67108864;
constexpr size_t OFF_M1 = OFF_QK, OFF_MB = OFF_VT, OFF_YF2 = OFF_GL, OFF_OB = OFF_HB;
constexpr size_t OFF_BAR = OFF_CB + 33554432;
constexpr size_t OFF_CNT = OFF_BAR + 16384;
constexpr size_t OFF_CEN = OFF_CNT + 16384;
constexpr size_t OFF_SLOT = OFF_CEN + 4096;
constexpr size_t WS_NEED = OFF_SLOT + 524288;

struct Params {
    const float* x; const float* w_in; const float* b_gate; const float* conv_w; const float* w_conv_out; const float* w_attn_out; const float* lam_vec; const float* subln_w;
    const float* w_o; const float* ffn1_w13; const float* ffn1_w2; const float* ffn2_w13; const float* ffn2_w2; const float* norm_w; float* out; unsigned char* ws;
};

typedef const __attribute__((address_space(4))) Params* KPtr_;
__device__ __forceinline__ void convert_weights(KPtr_ kp, int l, int t0, int t1, int bi, int nb) {
    Params p; p.ffn1_w13 = kp->ffn1_w13; p.ffn1_w2 = kp->ffn1_w2; p.ffn2_w13 = kp->ffn2_w13; p.ffn2_w2 = kp->ffn2_w2; p.w_in = kp->w_in; p.w_conv_out = kp->w_conv_out; p.w_attn_out = kp->w_attn_out; p.w_o = kp->w_o; unsigned char* ws = kp->ws;
    const int tid = opaque_tid(), n = tid & 63, kq = tid >> 6;
    for (int t = t0 + bi; t < t1; t += nb) {
        const float* src; bf16_t* dst; int K, ld, mode, tl;
        if (t < 352)       { tl = t;        src = p.ffn1_w13 + (size_t)l * 1024 * 5632; dst = (bf16_t*)(ws + OFF_W13A); K = 1024; ld = 5632; mode = 1; }
        else if (t < 528)  { tl = t - 352;  src = p.ffn1_w2 + (size_t)l * 2816 * 1024;  dst = (bf16_t*)(ws + OFF_W2A);  K = 2816; ld = 1024; mode = 0; }
        else if (t < 880)  { tl = t - 528;  src = p.ffn2_w13 + (size_t)l * 1024 * 5632; dst = (bf16_t*)(ws + OFF_W13B); K = 1024; ld = 5632; mode = 1; }
        else if (t < 1056) { tl = t - 880;  src = p.ffn2_w2 + (size_t)l * 2816 * 1024;  dst = (bf16_t*)(ws + OFF_W2B);  K = 2816; ld = 1024; mode = 0; }
        else if (t < 1568) { tl = t - 1056; src = p.w_in + (size_t)l * 1024 * 8192;     dst = (bf16_t*)(ws + OFF_WIN);  K = 1024; ld = 8192; mode = 2; }
        else if (t < 1632) { tl = t - 1568; src = p.w_conv_out + (size_t)l * 1048576;   dst = (bf16_t*)(ws + OFF_WCO);  K = 1024; ld = 1024; mode = 0; }
        else if (t < 1696) { tl = t - 1632; src = p.w_attn_out + (size_t)l * 1048576;   dst = (bf16_t*)(ws + OFF_WAO);  K = 1024; ld = 1024; mode = 0; }
        else               { tl = t - 1696; src = p.w_o + (size_t)l * 1048576;          dst = (bf16_t*)(ws + OFF_WO);   K = 1024; ld = 1024; mode = 0; }
        const int KT = K / 256, nb = tl / KT, kb = tl % KT, n0 = nb * 64; int src0 = n0;
        if (mode == 1) { const int pn = n0 >> 8, bj = (n0 >> 7) & 1, jj = n0 & 127; src0 = bj * DFF + pn * 128 + jj; }
        if (mode == 2) {
            if (n0 < 2048) { const int pn = n0 >> 8, bj = (n0 >> 7) & 1, jj = n0 & 127; src0 = 1024 + bj * 1024 + pn * 128 + jj; }
            else if (n0 < 3072) src0 = n0 - 2048;
            else src0 = (n0 < 5120) ? n0 : (n0 < 7168 ? n0 + 1024 : n0 - 2048); }
        const int k0 = kb * 256 + kq * 32;
        const float* sp = src + (size_t)k0 * ld + src0 + n;
        float v[32];
#pragma unroll
        for (int j = 0; j < 32; ++j) v[j] = sp[(size_t)j * ld];
        bf16_t* dp = dst + (size_t)(n0 + n) * K + k0;
#pragma unroll
        for (int q = 0; q < 4; ++q) { u32x4 w; w.x = pk_bf16(v[8 * q], v[8 * q + 1]); w.y = pk_bf16(v[8 * q + 2], v[8 * q + 3]); w.z = pk_bf16(v[8 * q + 4], v[8 * q + 5]); w.w = pk_bf16(v[8 * q + 6], v[8 * q + 7]);
            *(u32x4*)(dp + 8 * q) = w; }
    }
}
__device__ __forceinline__ void rope_tables(float* cs, float* sn) {
    for (int i = blockIdx.x * NTHR + opaque_tid(); i < SEQ * 8; i += gridDim.x * NTHR) {
        const int pos = i >> 3, j = i & 7;
        const float inv = (float)pow(500000.0, -(double)j / 8.0);
        const float ang = (float)pos * inv;
        cs[i] = (float)cos((double)ang); sn[i] = (float)sin((double)ang);
    }
}

__device__ __forceinline__ float sum16(float v) { v += __shfl_xor(v, 8); v += __shfl_xor(v, 4); v += __shfl_xor(v, 2); v += __shfl_xor(v, 1); return v; }
template <int MODE> __device__ __forceinline__ void row_phase(const float* xin, float* x, const bf16_t* y, const float* wpost, float scale, const float* wpre, bf16_t* h) {
    const int tid = opaque_tid(), lane = tid & 63, wid = tid >> 6, sub = lane >> 4, l16 = lane & 15;
    for (int row = (blockIdx.x * 8 + wid) * 4 + sub; row < MTOK; row += gridDim.x * 32) {
        const size_t ro = (size_t)row * DM + l16 * 4;
        f32x4 xv[16];
        if (MODE == 0 || MODE == 3) {
#pragma unroll
            for (int i = 0; i < 16; ++i) xv[i] = *(const f32x4*)(xin + ro + i * 64);
        } else {
            f32x4 yv[16]; float ss = 0.f;
#pragma unroll
            for (int i = 0; i < 16; ++i) { const u32x2 yw = *(const u32x2*)(y + ro + i * 64); yv[i] = (f32x4){bf_lo(yw.x), bf_hi(yw.x), bf_lo(yw.y), bf_hi(yw.y)}; xv[i] = *(const f32x4*)(x + ro + i * 64); }
#pragma unroll
            for (int i = 0; i < 16; ++i) ss += yv[i][0] * yv[i][0] + yv[i][1] * yv[i][1] + yv[i][2] * yv[i][2] + yv[i][3] * yv[i][3];
            ss = sum16(ss); const float rs = scale * __builtin_amdgcn_rsqf(ss * (1.0f / DM) + EPS);
#pragma unroll
            for (int i = 0; i < 16; ++i) { const f32x4 w = *(const f32x4*)(wpost + l16 * 4 + i * 64); xv[i] += yv[i] * rs * w; }
        }
        if (MODE != 3) {
#pragma unroll
            for (int i = 0; i < 16; ++i) *(f32x4*)(x + ro + i * 64) = xv[i]; }
        if (MODE != 2) {
            float ss = 0.f;
#pragma unroll
            for (int i = 0; i < 16; ++i) ss += xv[i][0] * xv[i][0] + xv[i][1] * xv[i][1] + xv[i][2] * xv[i][2] + xv[i][3] * xv[i][3];
            ss = sum16(ss); const float rs = __builtin_amdgcn_rsqf(ss * (1.0f / DM) + EPS);
#pragma unroll
            for (int i = 0; i < 16; ++i) { const f32x4 w = *(const f32x4*)(wpre + l16 * 4 + i * 64); const f32x4 v = xv[i] * rs * w;
                u32x2 o; o.x = pk_bf16(v[0], v[1]); o.y = pk_bf16(v[2], v[3]); *(u32x2*)(h + ro + i * 64) = o; }
        }
    }
}

__device__ __forceinline__ void ld8(const bf16_t* p, float (&v)[8]) { const u32x4 w = *(const u32x4*)p; v[0] = bf_lo(w.x); v[1] = bf_hi(w.x); v[2] = bf_lo(w.y); v[3] = bf_hi(w.y); v[4] = bf_lo(w.z); v[5] = bf_hi(w.z); v[6] = bf_lo(w.w); v[7] = bf_hi(w.w); }
__device__ __forceinline__ void conv_phase(const bf16_t* tb, const bf16_t* bb, const float* cw, bf16_t* cb) {
    for (int item = blockIdx.x * NTHR + opaque_tid(); item < 262144; item += gridDim.x * NTHR) {
        const int cgp = item & 127, chunk = item >> 7, c0 = cgp * 8, tok0 = chunk * 8, s0 = tok0 & (SEQ - 1);
        u32x4 tr[10], br[8];
        const u32x4 z4 = {0u, 0u, 0u, 0u};
#pragma unroll
        for (int i = 0; i < 10; ++i) { const int s = s0 - 1 + i; const bool ok = (s >= 0) && (s < SEQ); tr[i] = ok ? *(const u32x4*)(tb + (size_t)(tok0 - 1 + i) * DM + c0) : z4; }
#pragma unroll
        for (int i = 0; i < 8; ++i) br[i] = *(const u32x4*)(bb + (size_t)(tok0 + i) * DM + c0);
        float w0[8], w1[8], w2[8];
#pragma unroll
        for (int j = 0; j < 8; ++j) { w0[j] = cw[c0 + j]; w1[j] = cw[1024 + c0 + j]; w2[j] = cw[2048 + c0 + j]; }
        float tp[8], tc[8], tn[8];
#define CONV_T(dst, i) do { const u32x4 a_ = tr[i]; dst[0] = bf_lo(a_.x); dst[1] = bf_hi(a_.x); dst[2] = bf_lo(a_.y); dst[3] = bf_hi(a_.y); dst[4] = bf_lo(a_.z); dst[5] = bf_hi(a_.z); dst[6] = bf_lo(a_.w); dst[7] = bf_hi(a_.w); } while (0)
        CONV_T(tp, 0); CONV_T(tc, 1);
#pragma unroll
        for (int i = 0; i < 8; ++i) {
            CONV_T(tn, i + 2);
            const u32x4 bw = br[i]; const float bv[8] = {bf_lo(bw.x), bf_hi(bw.x), bf_lo(bw.y), bf_hi(bw.y), bf_lo(bw.z), bf_hi(bw.z), bf_lo(bw.w), bf_hi(bw.w)};
            float o[8];
#pragma unroll
            for (int j = 0; j < 8; ++j) { o[j] = bv[j] * (w0[j] * tp[j] + w1[j] * tc[j] + w2[j] * tn[j]); tp[j] = tc[j]; tc[j] = tn[j]; }
            u32x4 w; w.x = pk_bf16(o[0], o[1]); w.y = pk_bf16(o[2], o[3]); w.z = pk_bf16(o[4], o[5]); w.w = pk_bf16(o[6], o[7]);
            *(u32x4*)(cb + (size_t)(tok0 + i) * DM + c0) = w;
        }
#undef CONV_T
    }
}

#ifndef ATT_SCHED
#define ATT_SCHED 0
#endif
__device__ __forceinline__ float fmax3(float a, float b, float c) { return fmaxf(fmaxf(a, b), c); }
__device__ __forceinline__ void attn_phase(LAS unsigned char* lds, const bf16_t* qk, const bf16_t* vt, bf16_t* ob, const float* lv, const float* subln, float lam_init, int vcb) {
    const int tid = opaque_tid(), wid = __builtin_amdgcn_readfirstlane(tid >> 6), lane = tid & 63, r = lane & 31, hf = lane >> 5;
    const int c = wid >> 2, qw = wid & 3;
    float d1 = 0.f, d2 = 0.f;
    for (int i = 0; i < 64; ++i) { d1 += lv[i] * lv[64 + i]; d2 += lv[128 + i] * lv[192 + i]; }
    const float lam = expf(d1) - expf(d2) + lam_init;
    const int G = gridDim.x, cb = vcb;
    const int pr = (r & ~12) | ((r & 4) << 1) | ((r & 8) >> 1);
    const int ksw = (pr >> 1) & 7, vsw = (r >> 1) & 7;
    const int srow = tid >> 3, sch = tid & 7;
    for (int it = 0;; ++it) {
        const int u = it * G + cb; if (u >= 1024) break;
        int bh, qb;
        if (G == 256) { bh = it * 16 + (cb & 7) * 2 + (cb >> 7); qb = (cb >> 3) & 15; } else { bh = u >> 4; qb = u & 15; }
        const int b = bh >> 3, h = bh & 7;
        const size_t tok0 = (size_t)b * SEQ;
        const size_t qtok = tok0 + qb * 128 + qw * 32 + r;
        const bf16_t* qrow = qk + qtok * QK_LD + h * 128 + c * 64 + 8 * hf;
        bf16x8 Qf[4];
#pragma unroll
        for (int kk = 0; kk < 4; ++kk) Qf[kk] = *(const bf16x8*)(qrow + 16 * kk);
        f32x16 O[4];
#pragma unroll
        for (int d = 0; d < 4; ++d)
#pragma unroll
            for (int i = 0; i < 16; ++i) O[d][i] = 0.f;
        float rref = 0.f, runmax = -1e30f, lrun = 0.f;
        const int gch = sch ^ ((srow >> 1) & 7);
        const bf16_t* kg = qk + (tok0 + srow) * QK_LD + 1024 + h * 128 + gch * 8;
        const bf16_t* vg = vt + (size_t)(h * 128 + srow) * VT_LD + tok0 + gch * 8;
#define ATT_ISSUE(t) do { const int tt_ = ((t) + 2 * qb) & 31; LAS unsigned char* bs = lds + ((t) & 3) * 32768 + wid * 1024; \
            __builtin_amdgcn_global_load_lds((const unsigned*)(kg + (size_t)tt_ * 64 * QK_LD), (LAS unsigned*)(bs), 16, 0, 0); \
            __builtin_amdgcn_global_load_lds((const unsigned*)(kg + (size_t)tt_ * 64 * QK_LD + 64), (LAS unsigned*)(bs + 8192), 16, 0, 0); \
            __builtin_amdgcn_global_load_lds((const unsigned*)(vg + tt_ * 64), (LAS unsigned*)(bs + 16384), 16, 0, 0); \
            __builtin_amdgcn_global_load_lds((const unsigned*)(vg + tt_ * 64 + (size_t)64 * VT_LD), (LAS unsigned*)(bs + 24576), 16, 0, 0); } while (0)
#define ATT_KLD(buf) do { const LAS unsigned char* kb_ = lds + (buf) * 32768 + c * 8192 + pr * 128; \
            _Pragma("unroll") for (int kk = 0; kk < 4; ++kk) { const int off = ((2 * kk + hf) ^ ksw) << 4; Kf[kk] = *(const LAS bf16x8*)(kb_ + off); Kf[4 + kk] = *(const LAS bf16x8*)(kb_ + 32 * 128 + off); } } while (0)
#define ATT_QKM(D0, D1) do { const float ninit_ = -rref; _Pragma("unroll") for (int i = 0; i < 16; ++i) { D0[i] = ninit_; D1[i] = ninit_; } \
            _Pragma("unroll") for (int kk = 0; kk < 4; ++kk) { D0 = __builtin_amdgcn_mfma_f32_32x32x16_bf16(Kf[kk], Qf[kk], D0, 0, 0, 0); D1 = __builtin_amdgcn_mfma_f32_32x32x16_bf16(Kf[4 + kk], Qf[kk], D1, 0, 0, 0); } } while (0)
#define ATT_VLD(DST, buf, d0) do { const LAS unsigned char* vb_ = lds + (buf) * 32768 + 16384 + r * 128; \
            _Pragma("unroll") for (int dd = 0; dd < 2; ++dd) _Pragma("unroll") for (int kb = 0; kb < 2; ++kb) _Pragma("unroll") for (int s = 0; s < 2; ++s) \
                DST[dd * 4 + kb * 2 + s] = *(const LAS bf16x8*)(vb_ + ((d0) + dd) * 32 * 128 + (((4 * kb + 2 * s + hf) ^ vsw) << 4)); } while (0)
#define ATT_PVM(SRC, d0) do { _Pragma("unroll") for (int kb = 0; kb < 2; ++kb) _Pragma("unroll") for (int s = 0; s < 2; ++s) _Pragma("unroll") for (int dd = 0; dd < 2; ++dd) \
                O[(d0) + dd] = __builtin_amdgcn_mfma_f32_32x32x16_bf16(SRC[dd * 4 + kb * 2 + s], P[kb][s], O[(d0) + dd], 0, 0, 0); } while (0)
#define ATT_BAR() do { asm volatile("" ::: "memory"); __builtin_amdgcn_s_barrier(); asm volatile("" ::: "memory"); } while (0)
#define ATT_SB() __builtin_amdgcn_sched_barrier(0)
        ATT_ISSUE(0); ATT_ISSUE(1); if (c == 0) ATT_ISSUE(2);
        asm volatile("s_waitcnt vmcnt(0)" ::: "memory"); ATT_BAR();
        f32x16 S0, S1;
        bf16x8 Kf[8], VA[8];
        bf16x8 P[2][2];
        ATT_KLD(0); ATT_QKM(S0, S1);
#define ATT_PV(buf) do { ATT_VLD(VA, (buf), 0); ATT_SB(); ATT_PVM(VA, 0); ATT_SB(); ATT_VLD(VA, (buf), 2); ATT_SB(); ATT_PVM(VA, 2); ATT_SB(); } while (0)
        for (int t = 0; t < 32; ++t) {
            if (c == 1 && t < 30) ATT_ISSUE(t + 2);
            if (t > 0) ATT_PV((t - 1) & 3);
            if (c == 0) { asm volatile("s_waitcnt vmcnt(0)" ::: "memory"); ATT_BAR(); if (t < 29) ATT_ISSUE(t + 3); }
            ATT_KLD((t + 1) & 3);
            ATT_SB();
            float tm = fmaxf(S0[0], S1[0]);
#pragma unroll
            for (int i = 1; i < 16; ++i) tm = fmax3(tm, S0[i], S1[i]);
            tm = fmaxf(tm, __shfl_xor(tm, 32));
            runmax = fmaxf(runmax, tm);
            const bool up_ = tm > 11.5415603f, dn_ = runmax < -64.0f, upd = up_ || dn_;
            const float delta = up_ ? tm : (dn_ ? runmax : 0.0f), alpha = __builtin_amdgcn_exp2f(-delta);
            rref += delta; runmax -= delta;
            if (__builtin_amdgcn_ballot_w64(upd) != 0ull) {
#pragma unroll
                for (int i = 0; i < 16; ++i) { S0[i] -= delta; S1[i] -= delta; }
#pragma unroll
                for (int d = 0; d < 4; ++d)
#pragma unroll
                    for (int i = 0; i < 16; ++i) O[d][i] *= alpha;
            }
            ATT_SB();
            f32x16 N0, N1;
            ATT_QKM(N0, N1);
            float rs = 0.f;
#pragma unroll
            for (int i = 0; i < 16; ++i) { S0[i] = __builtin_amdgcn_exp2f(S0[i]); S1[i] = __builtin_amdgcn_exp2f(S1[i]); rs += S0[i] + S1[i]; }
            lrun = lrun * alpha + rs;
#pragma unroll
            for (int s = 0; s < 2; ++s) {
                u32x4 w0, w1;
                w0.x = pk_bf16(S0[8 * s + 0], S0[8 * s + 1]); w0.y = pk_bf16(S0[8 * s + 2], S0[8 * s + 3]); w0.z = pk_bf16(S0[8 * s + 4], S0[8 * s + 5]); w0.w = pk_bf16(S0[8 * s + 6], S0[8 * s + 7]);
                w1.x = pk_bf16(S1[8 * s + 0], S1[8 * s + 1]); w1.y = pk_bf16(S1[8 * s + 2], S1[8 * s + 3]); w1.z = pk_bf16(S1[8 * s + 4], S1[8 * s + 5]); w1.w = pk_bf16(S1[8 * s + 6], S1[8 * s + 7]);
                P[0][s] = __builtin_bit_cast(bf16x8, w0); P[1][s] = __builtin_bit_cast(bf16x8, w1);
            }
            ATT_SB();
            if (c == 1) { asm volatile("s_waitcnt vmcnt(0)" ::: "memory"); ATT_BAR(); }
            S0 = N0; S1 = N1;
        }
        ATT_PV(31 & 3);
#undef ATT_PV
#undef ATT_KLD
#undef ATT_QKM
#undef ATT_VLD
#undef ATT_PVM
#undef ATT_ISSUE
        const float lt = lrun + __shfl_xor(lrun, 32);
        LAS float* X = (LAS float*)lds + qw * 4096 + lane;
        if (c == 1) { const float sc = lam / lt;
#pragma unroll
            for (int d = 0; d < 4; ++d)
#pragma unroll
                for (int i = 0; i < 16; ++i) X[(d * 16 + i) * 64] = O[d][i] * sc; }
        __syncthreads();
        if (c == 0) { const float sc = 1.0f / lt; float ss = 0.f;
#pragma unroll
            for (int d = 0; d < 4; ++d)
#pragma unroll
                for (int i = 0; i < 16; ++i) { const float o = O[d][i] * sc - X[(d * 16 + i) * 64]; O[d][i] = o; ss += o * o; }
            ss += __shfl_xor(ss, 32);
            const float rms = __builtin_amdgcn_rsqf(ss * (1.0f / 128.0f) + EPS) * (1.0f - lam_init);
            bf16_t* orow = ob + qtok * DM + h * 128 + 4 * hf;
#pragma unroll
            for (int d = 0; d < 4; ++d)
#pragma unroll
                for (int g = 0; g < 4; ++g) { const int dv = 32 * d + 8 * g;
                    const f32x4 w = *(const f32x4*)(subln + dv + 4 * hf);
                    u32x2 o; o.x = pk_bf16(O[d][4 * g] * rms * w[0], O[d][4 * g + 1] * rms * w[1]); o.y = pk_bf16(O[d][4 * g + 2] * rms * w[2], O[d][4 * g + 3] * rms * w[3]);
                    *(u32x2*)(orow + dv) = o; } }
        __syncthreads();
    }
}
#define XB_TMO      128
#define XB_XCNT(j)  (256  + 64 * (j))
#define XB_XSUB(j)  (1280 + 64 * (j))
#define XB_XGEN(j)  (2304 + 64 * (j))
#define XB_TOP      3328
#define XB_TOPGEN   3392
#define XCD_BAR_WORDS 3456
#define XB_SPIN_CAP (1u << 18)

__device__ __forceinline__ unsigned xb_ld(unsigned* p)              { return __hip_atomic_load(p, __ATOMIC_RELAXED, __HIP_MEMORY_SCOPE_AGENT); }
__device__ __forceinline__ unsigned xb_add(unsigned* p, unsigned v) { return __hip_atomic_fetch_add(p, v, __ATOMIC_RELAXED, __HIP_MEMORY_SCOPE_AGENT); }
__device__ __forceinline__ unsigned xb_xcc_id() { return (unsigned)__builtin_amdgcn_s_getreg((3 << 11) | 20) & 0xFu; }
#define XB_SPIN(cond, bar) do { unsigned _sp = 0; while (cond) { __builtin_amdgcn_s_sleep(1); \
    if ((++_sp & 255u) == 0u) { if (xb_ld(&(bar)[XB_TMO])) break; if (_sp > XB_SPIN_CAP) { atomicAdd(&(bar)[XB_TMO], 1u); break; } } } } while (0)

struct XcdBarrier {
    unsigned* bar; unsigned x;
    volatile LAS unsigned* st;
};

__device__ __forceinline__ XcdBarrier xcd_barrier_post(unsigned* bar, volatile LAS unsigned* st) {
    XcdBarrier b; b.bar = bar; b.x = xb_xcc_id(); b.st = st;
    if (threadIdx.x == 0) (void)xb_add(&bar[XB_XCNT(b.x)], 1u);
    return b;
}
__device__ __forceinline__ void xcd_barrier_complete(unsigned* bar, unsigned x, unsigned& nloc, unsigned& nx) {
    const unsigned G = gridDim.x * gridDim.y * gridDim.z;
    unsigned sum, cnt, mine, sp = 0u;
    for (;;) {
        sum = 0u; cnt = 0u; mine = 0u;
#pragma unroll
        for (unsigned j = 0; j < 16; ++j) { const unsigned c = xb_ld(&bar[XB_XCNT(j)]); sum += c; cnt += (c > 0u) ? 1u : 0u; mine = (j == x) ? c : mine; }
        if (sum == G) break;
        __builtin_amdgcn_s_sleep(1);
        if ((++sp & 255u) == 0u) { if (xb_ld(&bar[XB_TMO])) break; if (sp > XB_SPIN_CAP) { atomicAdd(&bar[XB_TMO], 1u); break; } }
    }
    nloc = mine > 0u ? mine : 1u; nx = cnt > 0u ? cnt : 1u;
}

__device__ __forceinline__ void xcd_barrier(const XcdBarrier& b) {
    asm volatile("s_waitcnt vmcnt(0)" ::: "memory");
    __syncthreads();
    if (threadIdx.x == 0) {
        unsigned* bar = b.bar;
        __builtin_amdgcn_s_waitcnt(0);
        unsigned nloc = b.st[0], nx = b.st[1];
        if (nloc == 0u) { xcd_barrier_complete(bar, b.x, nloc, nx); b.st[0] = nloc; b.st[1] = nx; }
        const unsigned old = xb_add(&bar[XB_XSUB(b.x)], 1u);
        const unsigned gen = old / nloc;
        if (old + 1u == (gen + 1u) * nloc) {
            __builtin_amdgcn_fence(__ATOMIC_RELEASE, "agent");
            asm volatile("s_waitcnt vmcnt(0)" ::: "memory");
            const unsigned og = xb_add(&bar[XB_TOP], 1u);
            const unsigned tg = og / nx;
            if (og + 1u == (tg + 1u) * nx) xb_add(&bar[XB_TOPGEN], 1u);
            else XB_SPIN(xb_ld(&bar[XB_TOPGEN]) == tg, bar);
            __builtin_amdgcn_fence(__ATOMIC_ACQUIRE, "agent");
            xb_add(&bar[XB_XGEN(b.x)], 1u);
            asm volatile("s_waitcnt vmcnt(0)" ::: "memory");
        } else {
            XB_SPIN(xb_ld(&bar[XB_XGEN(b.x)]) == gen, bar);
            __builtin_amdgcn_fence(__ATOMIC_ACQUIRE, "agent");
            asm volatile("s_waitcnt vmcnt(0)" ::: "memory");
        }
    }
    __syncthreads();
}
#ifndef REP_GEMM
#define REP_GEMM 1
#endif
#ifndef REP_ATTN
#define REP_ATTN 1
#endif
#ifndef REP_CONV
#define REP_CONV 1
#endif
#ifndef REP_CVT
#define REP_CVT 1
#endif
#ifndef REP_SYNC
#define REP_SYNC 1
#endif
#define GSYNC() do { for (int rep_ = 0; rep_ < REP_SYNC; ++rep_) xcd_barrier(bar); } while (0)
template <class Epi> __device__ __forceinline__ void run_gemm_(LAS unsigned char* lds, const bf16_t* A, const bf16_t* Bt, int M, int N, int K, const Epi& E, int vcb) {
    pg8::Gemm g{A, Bt, M, N, K}; pg8::StaticOrder S; S.init(M, N, (int)gridDim.x, vcb);
    for (int rep = 0; rep < REP_GEMM; ++rep) pg8::gemm_phase<Epi, pg8::StaticOrder, false>(lds, g, S, E, nullptr);
}

typedef const __attribute__((address_space(4))) Params* KPtr;
__device__ __forceinline__ KPtr kparams() { KPtr kp = (KPtr)__builtin_amdgcn_kernarg_segment_ptr(); asm volatile("" : "+s"(kp)); return kp; }
#define WSP(T, off) ((T*)(kparams()->ws + (off)))
__device__ __forceinline__ int vcb_read(LAS unsigned char* lds) { unsigned off = 131072u + 8u; asm volatile("" : "+v"(off)); return (int)__builtin_amdgcn_readfirstlane(*(volatile LAS unsigned*)(lds + off)); }
#define VCB() vcb_read(lds)
#define run_gemm(...) run_gemm_(__VA_ARGS__, VCB())
template <bool fusedn> __global__ void __launch_bounds__(NTHR) fwd_megakernel(Params p_unused) {
    extern __shared__ __attribute__((aligned(16))) unsigned char smem[];
    cg::grid_group grid = cg::this_grid();
    LAS unsigned char* lds = (LAS unsigned char*)smem;
    if (threadIdx.x < 4) ((LAS unsigned*)(lds + 131072))[threadIdx.x] = 0u;
    __syncthreads();
    const XcdBarrier bar = xcd_barrier_post(WSP(unsigned, OFF_BAR), (volatile LAS unsigned*)(lds + 131072));
    if (threadIdx.x == 0) { unsigned* cen = WSP(unsigned, OFF_CEN); ((volatile LAS unsigned*)(lds + 131072))[3] = __hip_atomic_fetch_add(cen + 64 * bar.x, 1u, __ATOMIC_RELAXED, __HIP_MEMORY_SCOPE_AGENT); }

    { const KPtr kp = kparams(); for (int rep = 0; rep < REP_CVT; ++rep) convert_weights(kp, 0, 0, 528, (int)blockIdx.x, (int)gridDim.x); }
    rope_tables(WSP(float, OFF_TAB), WSP(float, OFF_TAB) + SEQ * 8);
    { const KPtr kp = kparams(); if constexpr (fusedn) row_phase<3>(kp->x, nullptr, nullptr, nullptr, 0.f, kp->norm_w, WSP(bf16_t, OFF_HB)); else row_phase<0>(kp->x, kp->out, nullptr, nullptr, 0.f, kp->norm_w, WSP(bf16_t, OFF_HB)); }
    grid.sync();
    if (threadIdx.x == 0) { unsigned* cen = WSP(unsigned, OFF_CEN); const unsigned per = gridDim.x >> 3; bool ok = (gridDim.x & 7u) == 0u && bar.x < 8u;
        for (int j = 0; j < 8; ++j) ok = ok && (__hip_atomic_load(cen + 64 * j, __ATOMIC_RELAXED, __HIP_MEMORY_SCOPE_AGENT) == per);
        volatile LAS unsigned* w = (volatile LAS unsigned*)(lds + 131072); w[2] = ok ? (w[3] * 8u + bar.x) : blockIdx.x; }
    __syncthreads();
    for (int l = 0; l < 2; ++l) {
        run_gemm(lds, WSP(bf16_t, OFF_HB), WSP(bf16_t, OFF_W13A), MTOK, 2 * DFF, DM, pg8::EpiGlu<true>{WSP(bf16_t, OFF_AB), DFF});
        { const int rem = 1408 % (int)gridDim.x, vc = VCB(); const KPtr kp = kparams();
          if (rem == 0) convert_weights(kp, l, 528, 1760, vc, (int)gridDim.x); else if (vc >= rem) convert_weights(kp, l, 528, 1760, vc - rem, (int)gridDim.x - rem); }
        GSYNC();
        if constexpr (fusedn) { const KPtr kp = kparams(); const float* nw = kp->norm_w + (size_t)l * 6 * DM;
            run_gemm(lds, WSP(bf16_t, OFF_AB), WSP(bf16_t, OFF_W2A), MTOK, DM, DFF, pg8::EpiNormRes{l == 0 ? kp->x : kp->out, kp->out, nw + DM, 0.5f, nw + 2 * DM, WSP(bf16_t, OFF_HB), WSP(float, OFF_SLOT), WSP(unsigned, OFF_CNT), (unsigned)(l * 6)}); }
        else { run_gemm(lds, WSP(bf16_t, OFF_AB), WSP(bf16_t, OFF_W2A), MTOK, DM, DFF, pg8::EpiBf16{WSP(bf16_t, OFF_YF1), DM, 0, nullptr, 0, nullptr, nullptr, 0, 0, 1.0f}); GSYNC();
            const KPtr kp = kparams(); const float* nw = kp->norm_w + (size_t)l * 6 * DM; row_phase<1>(nullptr, kp->out, WSP(bf16_t, OFF_YF1), nw + DM, 0.5f, nw + 2 * DM, WSP(bf16_t, OFF_HB)); }
        GSYNC();
        run_gemm(lds, WSP(bf16_t, OFF_HB), WSP(bf16_t, OFF_WIN), MTOK, 2048, DM, pg8::EpiGlu<false>{WSP(bf16_t, OFF_TCH), DM});
        run_gemm(lds, WSP(bf16_t, OFF_HB), WSP(bf16_t, OFF_WIN) + (size_t)2048 * DM, MTOK, 1024, DM, pg8::EpiBf16{WSP(bf16_t, OFF_BB), DM, 0, nullptr, 0, nullptr, nullptr, 0, 0, 1.0f});
        GSYNC();
        for (int rep = 0; rep < REP_CONV; ++rep) conv_phase(WSP(bf16_t, OFF_TCH), WSP(bf16_t, OFF_BB), kparams()->conv_w + (size_t)l * 3 * DM, WSP(bf16_t, OFF_CB));
        GSYNC();
        run_gemm(lds, WSP(bf16_t, OFF_HB), WSP(bf16_t, OFF_WIN) + (size_t)3072 * DM, MTOK, 4096, DM, pg8::EpiBf16{WSP(bf16_t, OFF_QK), QK_LD, 8, WSP(bf16_t, OFF_GL), 8, WSP(float, OFF_TAB), WSP(float, OFF_TAB) + SEQ * 8, 2048, 4, 0.125f * 1.44269504f});
        run_gemm(lds, WSP(bf16_t, OFF_WIN) + (size_t)7168 * DM, WSP(bf16_t, OFF_HB), DM, MTOK, DM, pg8::EpiBf16{WSP(bf16_t, OFF_VT), VT_LD, 0, nullptr, 0, nullptr, nullptr, 0, 0, 1.0f});
        GSYNC();
        { const KPtr kp = kparams(); const float lam_init = 0.8f - 0.6f * expf(-0.3f * (float)l);
          for (int rep = 0; rep < REP_ATTN; ++rep) attn_phase(lds, WSP(bf16_t, OFF_QK), WSP(bf16_t, OFF_VT), WSP(bf16_t, OFF_OB), kp->lam_vec + (size_t)l * 256, kp->subln_w + (size_t)l * 128, lam_init, VCB()); }
        GSYNC();
        run_gemm(lds, WSP(bf16_t, OFF_CB), WSP(bf16_t, OFF_WCO), MTOK, DM, DM, pg8::EpiGate<1>{WSP(bf16_t, OFF_GL), 2048, kparams()->b_gate + (size_t)l * 2048, WSP(bf16_t, OFF_M1), WSP(bf16_t, OFF_MB), DM});
        run_gemm(lds, WSP(bf16_t, OFF_OB), WSP(bf16_t, OFF_WAO), MTOK, DM, DM, pg8::EpiGate<2>{WSP(bf16_t, OFF_GL) + 1024, 2048, kparams()->b_gate + (size_t)l * 2048 + 1024, WSP(bf16_t, OFF_M1), WSP(bf16_t, OFF_MB), DM});
        GSYNC();
        if constexpr (fusedn) { const KPtr kp = kparams(); const float* nw = kp->norm_w + (size_t)l * 6 * DM;
            run_gemm(lds, WSP(bf16_t, OFF_MB), WSP(bf16_t, OFF_WO), MTOK, DM, DM, pg8::EpiNormRes{kp->out, kp->out, nw + 3 * DM, 1.0f, nw + 4 * DM, WSP(bf16_t, OFF_HB), WSP(float, OFF_SLOT), WSP(unsigned, OFF_CNT), (unsigned)(l * 6 + 2)}); }
        else { run_gemm(lds, WSP(bf16_t, OFF_MB), WSP(bf16_t, OFF_WO), MTOK, DM, DM, pg8::EpiBf16{WSP(bf16_t, OFF_YF2), DM, 0, nullptr, 0, nullptr, nullptr, 0, 0, 1.0f}); GSYNC();
            const KPtr kp = kparams(); const float* nw = kp->norm_w + (size_t)l * 6 * DM; row_phase<1>(nullptr, kp->out, WSP(bf16_t, OFF_YF2), nw + 3 * DM, 1.0f, nw + 4 * DM, WSP(bf16_t, OFF_HB)); }
        GSYNC();
        run_gemm(lds, WSP(bf16_t, OFF_HB), WSP(bf16_t, OFF_W13B), MTOK, 2 * DFF, DM, pg8::EpiGlu<true>{WSP(bf16_t, OFF_AB), DFF});
        if (l == 0) { const int rem = 1408 % (int)gridDim.x, vc = VCB(); const KPtr kp = kparams();
          if (rem == 0) convert_weights(kp, 1, 0, 528, vc, (int)gridDim.x); else if (vc >= rem) convert_weights(kp, 1, 0, 528, vc - rem, (int)gridDim.x - rem); }
        GSYNC();
        if constexpr (fusedn) { const KPtr kp = kparams(); const float* nw = kp->norm_w + (size_t)l * 6 * DM;
            run_gemm(lds, WSP(bf16_t, OFF_AB), WSP(bf16_t, OFF_W2B), MTOK, DM, DFF, pg8::EpiNormRes{kp->out, kp->out, nw + 5 * DM, 0.5f, nw + 6 * DM, l == 0 ? WSP(bf16_t, OFF_HB) : nullptr, WSP(float, OFF_SLOT), WSP(unsigned, OFF_CNT), (unsigned)(l * 6 + 4)}); }
        else { run_gemm(lds, WSP(bf16_t, OFF_AB), WSP(bf16_t, OFF_W2B), MTOK, DM, DFF, pg8::EpiBf16{WSP(bf16_t, OFF_YF1), DM, 0, nullptr, 0, nullptr, nullptr, 0, 0, 1.0f}); GSYNC();
            const KPtr kp = kparams(); const float* nw = kp->norm_w + (size_t)l * 6 * DM;
            if (l == 0) row_phase<1>(nullptr, kp->out, WSP(bf16_t, OFF_YF1), nw + 5 * DM, 0.5f, nw + 6 * DM, WSP(bf16_t, OFF_HB));
            else row_phase<2>(nullptr, kp->out, WSP(bf16_t, OFF_YF1), nw + 5 * DM, 0.5f, nullptr, nullptr); }
        if (l == 0) GSYNC();
    }
}

extern "C" void kernel_launch(void* const* d_in, const int* in_sizes, int n_in, void* d_out, int out_size, void* d_ws, size_t ws_size, hipStream_t stream) {
    static int grid_blocks = 0; static const void* kfn = nullptr;
    if (grid_blocks == 0) {
        if (ws_size < WS_NEED) { fprintf(stderr, "kernel_launch: workspace too small: %zu < %zu\n", ws_size, (size_t)WS_NEED); grid_blocks = -1; return; }
        int dev = 0, cus = 0, per_cu = 0;
        (void)hipGetDevice(&dev);
        (void)hipDeviceGetAttribute(&cus, hipDeviceAttributeMultiprocessorCount, dev);
        kfn = (cus == 256) ? (const void*)fwd_megakernel<true> : (const void*)fwd_megakernel<false>;
        if (hipFuncSetAttribute((const void*)kfn, hipFuncAttributeMaxDynamicSharedMemorySize, LDS_BYTES) != hipSuccess) { fprintf(stderr, "kernel_launch: hipFuncSetAttribute failed\n"); grid_blocks = -1; return; }
        if (hipOccupancyMaxActiveBlocksPerMultiprocessor(&per_cu, (const void*)kfn, NTHR, LDS_BYTES) != hipSuccess || per_cu < 1) { fprintf(stderr, "kernel_launch: occupancy query failed (%d)\n", per_cu); grid_blocks = -1; return; }
        grid_blocks = cus * 1;
        fprintf(stderr, "kernel_launch: cus %d per_cu %d grid %d ws %zu\n", cus, per_cu, grid_blocks, ws_size);
    }
    if (grid_blocks < 0) return;
    if (hipMemsetAsync((char*)d_ws + OFF_BAR, 0, 32768 + 4096, stream) != hipSuccess) { fprintf(stderr, "kernel_launch: memset failed\n"); return; }
    Params p{};
    p.x = (const float*)d_in[0]; p.w_in = (const float*)d_in[1]; p.b_gate = (const float*)d_in[2]; p.conv_w = (const float*)d_in[3]; p.w_conv_out = (const float*)d_in[4];
    p.w_attn_out = (const float*)d_in[5]; p.lam_vec = (const float*)d_in[6]; p.subln_w = (const float*)d_in[7]; p.w_o = (const float*)d_in[8];
    p.ffn1_w13 = (const float*)d_in[9]; p.ffn1_w2 = (const float*)d_in[10]; p.ffn2_w13 = (const float*)d_in[11]; p.ffn2_w2 = (const float*)d_in[12]; p.norm_w = (const float*)d_in[13];
    p.out = (float*)d_out; p.ws = (unsigned char*)d_ws;
    void* args[] = {&p};
    hipError_t e = hipLaunchCooperativeKernel((const void*)kfn, dim3(grid_blocks), dim3(NTHR), args, LDS_BYTES, stream);
    if (e != hipSuccess) fprintf(stderr, "cooperative launch failed: %s (grid %d)\n", hipGetErrorString(e), grid_blocks);
}
```

```cpp
#include <hip/hip_runtime.h>
#include <hip/hip_cooperative_groups.h>
#include <cstdio>
namespace cg = cooperative_groups;
__device__ __forceinline__ int opaque_tid() { int t = threadIdx.x; asm volatile("" : "+v"(t)); return t; }
namespace pg8 {
#define PG8_LAS __attribute__((address_space(3)))
typedef unsigned short bf16_t;
typedef short bf16x8 __attribute__((ext_vector_type(8)));
typedef float f32x4 __attribute__((ext_vector_type(4)));
typedef unsigned u32x4 __attribute__((ext_vector_type(4)));
constexpr int BM = 256, BK = 64, HALF = 128, HTB = HALF * BK * 2  , STAGE_BYTES = 8 * HTB, NXCD = 8, WGM = 8;

__host__ __device__ __forceinline__ int lds_byte(int r, int c) { const int st = (r >> 4) * 2 + (c >> 5), rr = r & 15, cc = c & 31, ob = rr * 64 + cc * 2; return st * 1024 + (ob ^ (((ob >> 9) & 1) << 5)); }
__host__ __device__ __forceinline__ void stage_rc(int b, int& R, int& C) { const int st = b / 1024, sb = b % 1024, swz = sb ^ (((sb >> 9) & 1) << 5); R = (st >> 1) * 16 + swz / 64; C = (st & 1) * 32 + (swz % 64) / 2; }
__host__ __device__ __forceinline__ int perm32(int rho) { const int n = rho >> 4, i = rho & 15; return 8 * (i >> 2) + 4 * n + (i & 3); }

struct Unit { int pm, pn; };
struct Gemm { const bf16_t* A; const bf16_t* Bt; int M, N, K; };

struct StaticOrder {
    int nM, nN, nwg, G, c;
    __host__ __device__ void init(int M, int N, int G_, int c_) { nM = M / BM; nN = N / BM; nwg = nM * nN; G = G_; c = c_; }
    __host__ __device__ bool next(int i, Unit& u) const {
        const long L = (long)i * G + c; if (L >= nwg) return false;
        int wgid = (int)L; { const int q = nwg / NXCD, r = nwg % NXCD, xcd = wgid % NXCD, off = wgid / NXCD; wgid = (xcd < r ? xcd * (q + 1) : r * (q + 1) + (xcd - r) * q) + off; }
        const int nig = WGM * nN, gid = wgid / nig, fm = gid * WGM, gsz = (nM - fm) < WGM ? (nM - fm) : WGM;
        u.pm = fm + ((wgid % nig) % gsz); u.pn = (wgid % nig) / gsz; return true;
    }
    __device__ __forceinline__ void a_ready(const Unit&) const {}
    __device__ __forceinline__ void done(const Unit&) const {}
};
template <class Epi, class Sched, bool STAMP = false>
__device__ __forceinline__ void gemm_phase(PG8_LAS unsigned char* lds, const Gemm g, const Sched& S, const Epi& E, unsigned long long* stamps) {
    const int tid = opaque_tid(), wid = __builtin_amdgcn_readfirstlane(tid >> 6), lane = tid & 63, wr = wid >> 2, wc = wid & 3, fr = lane & 15, fq = lane >> 4;
    const int K = g.K, nt = K / BK;
    int ts_lo = 0, ts_hi = 0, nts = 0; const unsigned long long rt_entry = STAMP ? (unsigned long long)wall_clock64() : 0ull;
#define PG8_STAMP() do { if (STAMP && wid == 0 && nts < 64) { const unsigned long long _c = (unsigned long long)clock64(); \
        ts_lo = (lane == nts) ? (int)(unsigned)_c : ts_lo; ts_hi = (lane == nts) ? (int)(unsigned)(_c >> 32) : ts_hi; ++nts; } } while (0)
    PG8_STAMP();
    unsigned voffA[2], voffB[2];
#pragma unroll
    for (int i = 0; i < 2; ++i) { int R, C; stage_rc(tid * 16 + i * 8192, R, C); const int Rb = Epi::PERM ? ((R & ~31) + perm32(R & 31)) : R;
        voffA[i] = (unsigned)(R * K + C) * 2u; voffB[i] = (unsigned)(Rb * K + C) * 2u; }
    const size_t kstep = (size_t)(BK * 2);
    const size_t hstep = (size_t)HALF * K * 2;
    const size_t tstep = 2 * hstep;
    const unsigned ldsw = (unsigned)wid * 1024u;
    const int aoff = lds_byte(wr * 64 + fr, fq * 8), boff = lds_byte(wc * 32 + fr, fq * 8);
#define PG8_SA(b, h) (((b) * 2 + (h)) * HTB)
#define PG8_SB(b, h) ((4 + (b) * 2 + (h)) * HTB)
#define PG8_STAGE(bufoff, gbase, voff) do { _Pragma("unroll") for (int _i = 0; _i < 2; ++_i) \
        __builtin_amdgcn_global_load_lds((const unsigned*)((const char*)(gbase) + (voff)[_i]), (PG8_LAS unsigned*)(lds + (bufoff) + ldsw + _i * 8192), 16, 0, 0); } while (0)
#define PG8_LDA(dst, b, h) do { _Pragma("unroll") for (int m = 0; m < 4; ++m) _Pragma("unroll") for (int k = 0; k < 2; ++k) dst[m][k] = *(const PG8_LAS bf16x8*)(lds + PG8_SA(b, h) + aoff + m * 2048 + k * 1024); } while (0)
#define PG8_LDB(dst, b, h) do { _Pragma("unroll") for (int n = 0; n < 2; ++n) _Pragma("unroll") for (int k = 0; k < 2; ++k) dst[n][k] = *(const PG8_LAS bf16x8*)(lds + PG8_SB(b, h) + boff + n * 2048 + k * 1024); } while (0)
#define PG8_MMA(ai, bj, At, Bt) do { __builtin_amdgcn_s_setprio(1); _Pragma("unroll") for (int m = 0; m < 4; ++m) _Pragma("unroll") for (int n = 0; n < 2; ++n) _Pragma("unroll") for (int k = 0; k < 2; ++k) \
        acc[ai][bj][m][n] = __builtin_amdgcn_mfma_f32_16x16x32_bf16(Bt[n][k], At[m][k], acc[ai][bj][m][n], 0, 0, 0); __builtin_amdgcn_s_setprio(0); } while (0)
#define PG8_WAIT_V(n) asm volatile("s_waitcnt vmcnt(" #n ")" ::: "memory")
#define PG8_WAIT_L(n) asm volatile("s_waitcnt lgkmcnt(" #n ")" ::: "memory")
#define PG8_BAR __builtin_amdgcn_s_barrier()
#define PG8_SCHED __builtin_amdgcn_sched_barrier(0)
    Unit cur, nxt; int ui = 0;
    if (!S.next(0, cur)) return;
    f32x4 acc[2][2][4][2];
#pragma unroll
    for (int a = 0; a < 2; ++a)
#pragma unroll
        for (int b = 0; b < 2; ++b)
#pragma unroll
            for (int m = 0; m < 4; ++m)
#pragma unroll
                for (int n = 0; n < 2; ++n) acc[a][b][m][n] = (f32x4){0.f, 0.f, 0.f, 0.f};
    bf16x8 At[4][2], B0[2][2], B1[2][2];
    const char* cA = (const char*)g.A + (size_t)cur.pm * tstep; const char* cB = (const char*)g.Bt + (size_t)cur.pn * tstep;
    S.a_ready(cur);
    PG8_STAGE(PG8_SB(0, 0), cB, voffB); PG8_STAGE(PG8_SA(0, 0), cA, voffA); PG8_STAGE(PG8_SB(0, 1), cB + hstep, voffB); PG8_STAGE(PG8_SA(0, 1), cA + hstep, voffA);
    if (wr == 1) PG8_BAR;
    PG8_WAIT_V(4); PG8_BAR;
    PG8_STAGE(PG8_SB(1, 0), cB + kstep, voffB); PG8_STAGE(PG8_SA(1, 0), cA + kstep, voffA); PG8_STAGE(PG8_SB(1, 1), cB + hstep + kstep, voffB);
    PG8_WAIT_V(6); PG8_BAR;
    PG8_STAMP();
    for (;;) {
        const bool has_next = S.next(ui + 1, nxt);
        const char* nA = has_next ? (const char*)g.A + (size_t)nxt.pm * tstep : cA; const char* nB = has_next ? (const char*)g.Bt + (size_t)nxt.pn * tstep : cB;
        for (int t = 0; t < nt; t += 2) {
            const bool last = (t == nt - 2);
            const char* a1 = cA + (size_t)(t + 1) * kstep;
            const char* a2 = last ? nA : cA + (size_t)(t + 2) * kstep; const char* b2 = last ? nB : cB + (size_t)(t + 2) * kstep;
            const char* a3 = a2 + kstep; const char* b3 = b2 + kstep;
            if (last && has_next) S.a_ready(nxt);
            PG8_LDB(B0, 0, 0); PG8_SCHED; PG8_LDA(At, 0, 0); PG8_STAGE(PG8_SA(1, 1), a1 + hstep, voffA);
            PG8_WAIT_L(8); PG8_BAR; PG8_WAIT_L(0); PG8_MMA(0, 0, At, B0); PG8_BAR; PG8_SCHED;
            PG8_LDB(B1, 0, 1); PG8_STAGE(PG8_SB(0, 0), b2, voffB);
            PG8_BAR; PG8_WAIT_L(0); PG8_MMA(0, 1, At, B1); PG8_BAR;
            PG8_LDA(At, 0, 1); PG8_STAGE(PG8_SA(0, 0), a2, voffA);
            PG8_BAR; PG8_WAIT_L(0); PG8_MMA(1, 0, At, B0); PG8_BAR; PG8_SCHED;
            PG8_STAGE(PG8_SB(0, 1), b2 + hstep, voffB);
            PG8_WAIT_V(6); PG8_BAR; PG8_MMA(1, 1, At, B1); PG8_BAR;
            PG8_LDB(B0, 1, 0); PG8_SCHED; PG8_LDA(At, 1, 0); PG8_STAGE(PG8_SA(0, 1), a2 + hstep, voffA);
            PG8_WAIT_L(8); PG8_BAR; PG8_WAIT_L(0); PG8_MMA(0, 0, At, B0); PG8_BAR; PG8_SCHED;
            PG8_LDB(B1, 1, 1); PG8_STAGE(PG8_SB(1, 0), b3, voffB);
            PG8_BAR; PG8_WAIT_L(0); PG8_MMA(0, 1, At, B1); PG8_BAR;
            PG8_LDA(At, 1, 1); PG8_STAGE(PG8_SA(1, 0), a3, voffA);
            PG8_BAR; PG8_WAIT_L(0); PG8_MMA(1, 0, At, B0); PG8_BAR; PG8_SCHED;
            PG8_STAGE(PG8_SB(1, 1), b3 + hstep, voffB);
            PG8_WAIT_V(6); PG8_BAR; PG8_MMA(1, 1, At, B1); PG8_BAR;
        }
        PG8_STAMP();
        if constexpr (!Epi::AFTER_DRAIN) { E(acc, cur, wr, wc, fr, fq); S.done(cur); }
        PG8_STAMP();
        if (!has_next) break;
#pragma unroll
        for (int a = 0; a < 2; ++a)
#pragma unroll
            for (int b = 0; b < 2; ++b)
#pragma unroll
                for (int m = 0; m < 4; ++m)
#pragma unroll
                    for (int n = 0; n < 2; ++n) acc[a][b][m][n] = (f32x4){0.f, 0.f, 0.f, 0.f};
        cur = nxt; cA = nA; cB = nB; ++ui;
    }
    PG8_WAIT_V(0);
    if (wr == 0) PG8_BAR;
    PG8_BAR;
    if constexpr (Epi::AFTER_DRAIN) { E.fused(acc, cur, wr, wc, fr, fq, lds, wid, lane); S.done(cur); }
    PG8_STAMP();
    if (STAMP && wid == 0) { stamps[lane] = lane < nts ? (((unsigned long long)(unsigned)ts_hi << 32) | (unsigned)ts_lo) : 0ull;
        if (lane == 62) stamps[62] = rt_entry; if (lane == 63) stamps[63] = (unsigned long long)wall_clock64(); }
#undef PG8_STAMP
#undef PG8_SA
#undef PG8_SB
#undef PG8_STAGE
#undef PG8_LDA
#undef PG8_LDB
#undef PG8_MMA
#undef PG8_WAIT_V
#undef PG8_WAIT_L
#undef PG8_BAR
#undef PG8_SCHED
}
typedef float f32x2 __attribute__((ext_vector_type(2)));
typedef unsigned u32x2v __attribute__((ext_vector_type(2)));
typedef __bf16 bf2_t __attribute__((ext_vector_type(2)));
__device__ __forceinline__ unsigned pk_bf16(float a, float b) { f32x2 v = {a, b}; bf2_t r = __builtin_convertvector(v, bf2_t); return __builtin_bit_cast(unsigned, r); }
__device__ __forceinline__ float bf_lo(unsigned w) { return __uint_as_float(w << 16); }
__device__ __forceinline__ float bf_hi(unsigned w) { return __uint_as_float(w & 0xffff0000u); }
__device__ __forceinline__ float sigmoidf_(float x) { return __builtin_amdgcn_rcpf(1.0f + __builtin_amdgcn_exp2f(-1.44269504f * x)); }

struct EpiF32 {
    static constexpr bool PERM = false, AFTER_DRAIN = false;
    float* C; int ldc;
    __device__ __forceinline__ void operator()(const f32x4 (&acc)[2][2][4][2], const Unit& u, int wr, int wc, int fr, int fq) const {
        const int row0 = u.pm * BM + wr * 64 + fr, col0 = u.pn * BM + wc * 32 + 4 * fq;
#pragma unroll
        for (int ai = 0; ai < 2; ++ai)
#pragma unroll
            for (int m = 0; m < 4; ++m) { float* rowp = C + (size_t)(row0 + ai * HALF + m * 16) * ldc + col0;
#pragma unroll
                for (int bj = 0; bj < 2; ++bj)
#pragma unroll
                    for (int n = 0; n < 2; ++n) *(f32x4*)(rowp + bj * HALF + n * 16) = acc[ai][bj][m][n]; }
    }
};
template <bool ACT> struct EpiGlu {
    static constexpr bool PERM = true, AFTER_DRAIN = false;
    bf16_t* O; int ldc;
    __device__ __forceinline__ void operator()(const f32x4 (&acc)[2][2][4][2], const Unit& u, int wr, int wc, int fr, int fq) const {
        const int row0 = u.pm * BM + wr * 64 + fr, col0 = u.pn * HALF + wc * 32 + 8 * fq;
#pragma unroll
        for (int ai = 0; ai < 2; ++ai)
#pragma unroll
            for (int m = 0; m < 4; ++m) { bf16_t* rowp = O + (size_t)(row0 + ai * HALF + m * 16) * ldc + col0;
                float v[8];
#pragma unroll
                for (int n = 0; n < 2; ++n)
#pragma unroll
                    for (int j = 0; j < 4; ++j) { const float g = acc[ai][0][m][n][j], up = acc[ai][1][m][n][j]; v[n * 4 + j] = ACT ? g * sigmoidf_(g) * up : g * up; }
                u32x4 w; w.x = pk_bf16(v[0], v[1]); w.y = pk_bf16(v[2], v[3]); w.z = pk_bf16(v[4], v[5]); w.w = pk_bf16(v[6], v[7]);
                *(u32x4*)rowp = w; }
    }
};
struct EpiBf16 {
    static constexpr bool PERM = true, AFTER_DRAIN = false;
    bf16_t* O; int ldc; int split_tiles; bf16_t* O2; int rope_tiles; const float* cs; const float* sn; int ldc2;
    __device__ __forceinline__ void operator()(const f32x4 (&acc)[2][2][4][2], const Unit& u, int wr, int wc, int fr, int fq) const {
        const int row0 = u.pm * BM + wr * 64 + fr; int pn = u.pn; bf16_t* base = O; int ld = ldc;
        if (split_tiles && pn >= split_tiles) { base = O2; pn -= split_tiles; ld = ldc2; }
        const int col0 = pn * BM + wc * 32 + 8 * fq;
        const bool rope = (u.pn < rope_tiles) && ((wc & 1) == 0);
#pragma unroll
        for (int ai = 0; ai < 2; ++ai)
#pragma unroll
            for (int m = 0; m < 4; ++m) { const int row = row0 + ai * HALF + m * 16; bf16_t* rowp = base + (size_t)row * ld + col0;
                f32x4 c0 = {1.f, 1.f, 1.f, 1.f}, c1 = c0, s0 = {0.f, 0.f, 0.f, 0.f}, s1 = s0;
                if (rope) { const int pos = row & 2047; c0 = *(const f32x4*)(cs + pos * 8); c1 = *(const f32x4*)(cs + pos * 8 + 4); s0 = *(const f32x4*)(sn + pos * 8); s1 = *(const f32x4*)(sn + pos * 8 + 4);
                    if (fq == 0) { s0 = -s0; s1 = -s1; } if (fq >= 2) { c0 = (f32x4){1.f, 1.f, 1.f, 1.f}; c1 = c0; s0 = (f32x4){0.f, 0.f, 0.f, 0.f}; s1 = s0; } }
#pragma unroll
                for (int bj = 0; bj < 2; ++bj) { f32x4 v0 = acc[ai][bj][m][0], v1 = acc[ai][bj][m][1];
                    if (rope) { f32x4 p0, p1;
#pragma unroll
                        for (int j = 0; j < 4; ++j) { p0[j] = __shfl_xor(v0[j], 16); p1[j] = __shfl_xor(v1[j], 16); }
                        v0 = v0 * c0 + p0 * s0; v1 = v1 * c1 + p1 * s1; }
                    u32x4 w; w.x = pk_bf16(v0[0], v0[1]); w.y = pk_bf16(v0[2], v0[3]); w.z = pk_bf16(v1[0], v1[1]); w.w = pk_bf16(v1[2], v1[3]);
                    *(u32x4*)(rowp + bj * HALF) = w; } }
    }
};
template <int PASS> struct EpiGate {
    static constexpr bool PERM = true, AFTER_DRAIN = false;
    const bf16_t* gl; int ldg; const float* bg; bf16_t* m1; bf16_t* mb; int ldc;
    __device__ __forceinline__ void operator()(const f32x4 (&acc)[2][2][4][2], const Unit& u, int wr, int wc, int fr, int fq) const {
        const int row0 = u.pm * BM + wr * 64 + fr, col0 = u.pn * BM + wc * 32 + 8 * fq;
#pragma unroll
        for (int bj = 0; bj < 2; ++bj) { const int col = col0 + bj * HALF;
            const f32x4 b0 = *(const f32x4*)(bg + col), b1 = *(const f32x4*)(bg + col + 4);
#pragma unroll
            for (int ai = 0; ai < 2; ++ai)
#pragma unroll
                for (int m = 0; m < 4; ++m) { const size_t row = (size_t)(row0 + ai * HALF + m * 16);
                    const u32x4 gw = *(const u32x4*)(gl + row * ldg + col);
                    f32x4 g0 = {bf_lo(gw.x), bf_hi(gw.x), bf_lo(gw.y), bf_hi(gw.y)}, g1 = {bf_lo(gw.z), bf_hi(gw.z), bf_lo(gw.w), bf_hi(gw.w)};
                    g0 += b0; g1 += b1; f32x4 v0 = acc[ai][bj][m][0], v1 = acc[ai][bj][m][1];
#pragma unroll
                    for (int j = 0; j < 4; ++j) { v0[j] *= sigmoidf_(g0[j]); v1[j] *= sigmoidf_(g1[j]); }
                    bf16_t* mp = m1 + row * ldc + col;
                    if (PASS == 2) { const u32x4 pw = *(const u32x4*)mp;
                        v0 += (f32x4){bf_lo(pw.x), bf_hi(pw.x), bf_lo(pw.y), bf_hi(pw.y)}; v1 += (f32x4){bf_lo(pw.z), bf_hi(pw.z), bf_lo(pw.w), bf_hi(pw.w)}; }
                    u32x4 w; w.x = pk_bf16(v0[0], v0[1]); w.y = pk_bf16(v0[2], v0[3]); w.z = pk_bf16(v1[0], v1[1]); w.w = pk_bf16(v1[2], v1[3]);
                    *(u32x4*)((PASS == 1 ? mp : mb + row * ldc + col)) = w; } }
    }
};
struct EpiNormRes {
    static constexpr bool PERM = false, AFTER_DRAIN = true;
    const float* xin; float* x; const float* wpost; float scale; const float* wpre; bf16_t* h; float* slots; unsigned* cnt; unsigned ex0;
    __device__ __forceinline__ void stats(const f32x4 (&v)[2][2][4][2], const Unit& u, int wr, int wc, int fr, int fq, PG8_LAS unsigned char* lds, int wid, int lane, unsigned ex) const {
        PG8_LAS float* P = (PG8_LAS float*)lds;
        PG8_LAS float* S = (PG8_LAS float*)(lds + 4096);
#pragma unroll
        for (int ai = 0; ai < 2; ++ai)
#pragma unroll
            for (int m = 0; m < 4; ++m) { float s = 0.f;
#pragma unroll
                for (int bj = 0; bj < 2; ++bj)
#pragma unroll
                    for (int n = 0; n < 2; ++n) { const f32x4 t = v[ai][bj][m][n]; s += (t[0] * t[0] + t[1] * t[1]) + (t[2] * t[2] + t[3] * t[3]); }
                s += __shfl_xor(s, 16); s += __shfl_xor(s, 32);
                if (fq == 0) P[(ai * HALF + wr * 64 + m * 16 + fr) * 4 + wc] = s; }
        asm volatile("s_waitcnt lgkmcnt(0)" ::: "memory"); __builtin_amdgcn_s_barrier(); asm volatile("" ::: "memory");
        const int row = wid * 32 + (lane & 31);
        float* slot = slots + ((size_t)(ex & 1u) * 16384 + (size_t)(u.pm * BM + row)) * 4;
        if (lane < 32) { const float tot = (P[row * 4 + 0] + P[row * 4 + 1]) + (P[row * 4 + 2] + P[row * 4 + 3]);
            __hip_atomic_store(slot + u.pn, tot, __ATOMIC_RELAXED, __HIP_MEMORY_SCOPE_AGENT); }
        asm volatile("s_waitcnt vmcnt(0)" ::: "memory");
        if (lane == 0) __hip_atomic_fetch_add(cnt + 64 * u.pm, 1u, __ATOMIC_RELAXED, __HIP_MEMORY_SCOPE_AGENT);
        if (wid == 0) { const unsigned want = 32u * (ex + 1u); unsigned spins = 0;
            while ((unsigned)__builtin_amdgcn_readfirstlane(__hip_atomic_load(cnt + 64 * u.pm, __ATOMIC_RELAXED, __HIP_MEMORY_SCOPE_AGENT)) < want) { __builtin_amdgcn_s_sleep(2); if (++spins > (1u << 22)) break; }
            __builtin_amdgcn_fence(__ATOMIC_ACQUIRE, "agent"); }
        asm volatile("s_waitcnt vmcnt(0) lgkmcnt(0)" ::: "memory"); __builtin_amdgcn_s_barrier(); asm volatile("" ::: "memory");
        if (lane < 32) { float q = 0.f;
#pragma unroll
            for (int t = 0; t < 4; ++t) q += __hip_atomic_load(slot + t, __ATOMIC_RELAXED, __HIP_MEMORY_SCOPE_AGENT);
            S[row] = __builtin_amdgcn_rsqf(q * (1.0f / 1024.0f) + 1e-6f); }
        asm volatile("s_waitcnt vmcnt(0) lgkmcnt(0)" ::: "memory"); __builtin_amdgcn_s_barrier(); asm volatile("" ::: "memory");
    }
    __device__ __forceinline__ void fused(f32x4 (&acc)[2][2][4][2], const Unit& u, int wr, int wc, int fr, int fq, PG8_LAS unsigned char* lds, int wid, int lane) const {
        const PG8_LAS float* S = (const PG8_LAS float*)(lds + 4096);
        const int col0 = u.pn * BM + wc * 32 + 4 * fq;
        stats(acc, u, wr, wc, fr, fq, lds, wid, lane, ex0);
#pragma unroll
        for (int ai = 0; ai < 2; ++ai)
#pragma unroll
            for (int m = 0; m < 4; ++m) { const int r = ai * HALF + wr * 64 + m * 16 + fr; const float rs = S[r] * scale; const size_t off = (size_t)(u.pm * BM + r) * 1024 + col0;
#pragma unroll
                for (int bj = 0; bj < 2; ++bj)
#pragma unroll
                    for (int n = 0; n < 2; ++n) { const f32x4 xv = *(const f32x4*)(xin + off + bj * HALF + n * 16); const f32x4 w = *(const f32x4*)(wpost + col0 + bj * HALF + n * 16);
                        const f32x4 o = xv + acc[ai][bj][m][n] * rs * w; acc[ai][bj][m][n] = o; *(f32x4*)(x + off + bj * HALF + n * 16) = o; }
                asm volatile("" : "+v"(acc[ai][0][m][0]), "+v"(acc[ai][0][m][1]), "+v"(acc[ai][1][m][0]), "+v"(acc[ai][1][m][1]));
                if (m & 1) asm volatile("" ::: "memory"); }
        if (h == nullptr) return;
        stats(acc, u, wr, wc, fr, fq, lds, wid, lane, ex0 + 1u);
#pragma unroll
        for (int ai = 0; ai < 2; ++ai)
#pragma unroll
            for (int m = 0; m < 4; ++m) { const int r = ai * HALF + wr * 64 + m * 16 + fr; const float rs = S[r]; const size_t off = (size_t)(u.pm * BM + r) * 1024 + col0;
#pragma unroll
                for (int bj = 0; bj < 2; ++bj)
#pragma unroll
                    for (int n = 0; n < 2; ++n) { const f32x4 w = *(const f32x4*)(wpre + col0 + bj * HALF + n * 16); const f32x4 o = acc[ai][bj][m][n] * rs * w;
                        u32x2v ov; ov.x = pk_bf16(o[0], o[1]); ov.y = pk_bf16(o[2], o[3]); *(u32x2v*)(h + off + bj * HALF + n * 16) = ov; } }
    }
};
}
#define LAS __attribute__((address_space(3)))
typedef unsigned short bf16_t;
typedef short bf16x8 __attribute__((ext_vector_type(8)));
typedef float f32x4 __attribute__((ext_vector_type(4)));
typedef float f32x16 __attribute__((ext_vector_type(16)));
typedef unsigned u32x4 __attribute__((ext_vector_type(4)));
typedef unsigned u32x2 __attribute__((ext_vector_type(2)));
using pg8::pk_bf16; using pg8::bf_lo; using pg8::bf_hi;

constexpr int MTOK = 16384, DM = 1024, SEQ = 2048, DFF = 2816, NTHR = 512;
constexpr int LDS_BYTES = 131072 + 16;
constexpr float EPS = 1e-6f;
constexpr size_t OFF_W13A = 0, OFF_W2A = 11534336, OFF_W13B = 17301504, OFF_W2B = 28835840, OFF_WIN = 34603008, OFF_WCO = 51380224, OFF_WAO = 53477376, OFF_WO = 55574528;
constexpr size_t OFF_HB = 57671680, OFF_TAB = OFF_HB + 33554432, OFF_RB = OFF_TAB + 131072;
constexpr size_t OFF_AB = OFF_RB, OFF_YF1 = OFF_RB + 92274688;
constexpr size_t OFF_TCH = OFF_RB, OFF_BB = OFF_RB + 33554432;
constexpr int QK_LD = 2048 + 128, VT_LD = 16384 + 128;
constexpr size_t OFF_QK = OFF_RB, OFF_VT = OFF_QK + (size_t)MTOK * QK_LD * 2, OFF_GL = OFF_VT + (size_t)1024 * VT_LD * 2, OFF_CB = OFF_GL + 67108864;
constexpr size_t OFF_M1 = OFF_QK, OFF_MB = OFF_VT, OFF_YF2 = OFF_GL, OFF_OB = OFF_HB;
constexpr size_t OFF_BAR = OFF_CB + 33554432;
constexpr size_t OFF_CNT = OFF_BAR + 16384;
constexpr size_t OFF_CEN = OFF_CNT + 16384;
constexpr size_t OFF_SLOT = OFF_CEN + 4096;
constexpr size_t WS_NEED = OFF_SLOT + 524288;

struct Params {
    const float* x; const float* w_in; const float* b_gate; const float* conv_w; const float* w_conv_out; const float* w_attn_out; const float* lam_vec; const float* subln_w;
    const float* w_o; const float* ffn1_w13; const float* ffn1_w2; const float* ffn2_w13; const float* ffn2_w2; const float* norm_w; float* out; unsigned char* ws;
};

typedef const __attribute__((address_space(4))) Params* KPtr_;
__device__ __forceinline__ void convert_weights(KPtr_ kp, int l, int t0, int t1, int bi, int nb) {
    Params p; p.ffn1_w13 = kp->ffn1_w13; p.ffn1_w2 = kp->ffn1_w2; p.ffn2_w13 = kp->ffn2_w13; p.ffn2_w2 = kp->ffn2_w2; p.w_in = kp->w_in; p.w_conv_out = kp->w_conv_out; p.w_attn_out = kp->w_attn_out; p.w_o = kp->w_o; unsigned char* ws = kp->ws;
    const int tid = opaque_tid(), n = tid & 63, kq = tid >> 6;
    for (int t = t0 + bi; t < t1; t += nb) {
        const float* src; bf16_t* dst; int K, ld, mode, tl;
        if (t < 352)       { tl = t;        src = p.ffn1_w13 + (size_t)l * 1024 * 5632; dst = (bf16_t*)(ws + OFF_W13A); K = 1024; ld = 5632; mode = 1; }
        else if (t < 528)  { tl = t - 352;  src = p.ffn1_w2 + (size_t)l * 2816 * 1024;  dst = (bf16_t*)(ws + OFF_W2A);  K = 2816; ld = 1024; mode = 0; }
        else if (t < 880)  { tl = t - 528;  src = p.ffn2_w13 + (size_t)l * 1024 * 5632; dst = (bf16_t*)(ws + OFF_W13B); K = 1024; ld = 5632; mode = 1; }
        else if (t < 1056) { tl = t - 880;  src = p.ffn2_w2 + (size_t)l * 2816 * 1024;  dst = (bf16_t*)(ws + OFF_W2B);  K = 2816; ld = 1024; mode = 0; }
        else if (t < 1568) { tl = t - 1056; src = p.w_in + (size_t)l * 1024 * 8192;     dst = (bf16_t*)(ws + OFF_WIN);  K = 1024; ld = 8192; mode = 2; }
        else if (t < 1632) { tl = t - 1568; src = p.w_conv_out + (size_t)l * 1048576;   dst = (bf16_t*)(ws + OFF_WCO);  K = 1024; ld = 1024; mode = 0; }
        else if (t < 1696) { tl = t - 1632; src = p.w_attn_out + (size_t)l * 1048576;   dst = (bf16_t*)(ws + OFF_WAO);  K = 1024; ld = 1024; mode = 0; }
        else               { tl = t - 1696; src = p.w_o + (size_t)l * 1048576;          dst = (bf16_t*)(ws + OFF_WO);   K = 1024; ld = 1024; mode = 0; }
        const int KT = K / 256, nb = tl / KT, kb = tl % KT, n0 = nb * 64; int src0 = n0;
        if (mode == 1) { const int pn = n0 >> 8, bj = (n0 >> 7) & 1, jj = n0 & 127; src0 = bj * DFF + pn * 128 + jj; }
        if (mode == 2) {
            if (n0 < 2048) { const int pn = n0 >> 8, bj = (n0 >> 7) & 1, jj = n0 & 127; src0 = 1024 + bj * 1024 + pn * 128 + jj; }
            else if (n0 < 3072) src0 = n0 - 2048;
            else src0 = (n0 < 5120) ? n0 : (n0 < 7168 ? n0 + 1024 : n0 - 2048); }
        const int k0 = kb * 256 + kq * 32;
        const float* sp = src + (size_t)k0 * ld + src0 + n;
        float v[32];
#pragma unroll
        for (int j = 0; j < 32; ++j) v[j] = sp[(size_t)j * ld];
        bf16_t* dp = dst + (size_t)(n0 + n) * K + k0;
#pragma unroll
        for (int q = 0; q < 4; ++q) { u32x4 w; w.x = pk_bf16(v[8 * q], v[8 * q + 1]); w.y = pk_bf16(v[8 * q + 2], v[8 * q + 3]); w.z = pk_bf16(v[8 * q + 4], v[8 * q + 5]); w.w = pk_bf16(v[8 * q + 6], v[8 * q + 7]);
            *(u32x4*)(dp + 8 * q) = w; }
    }
}
__device__ __forceinline__ void rope_tables(float* cs, float* sn) {
    for (int i = blockIdx.x * NTHR + opaque_tid(); i < SEQ * 8; i += gridDim.x * NTHR) {
        const int pos = i >> 3, j = i & 7;
        const float inv = (float)pow(500000.0, -(double)j / 8.0);
        const float ang = (float)pos * inv;
        cs[i] = (float)cos((double)ang); sn[i] = (float)sin((double)ang);
    }
}

__device__ __forceinline__ float sum16(float v) { v += __shfl_xor(v, 8); v += __shfl_xor(v, 4); v += __shfl_xor(v, 2); v += __shfl_xor(v, 1); return v; }
template <int MODE> __device__ __forceinline__ void row_phase(const float* xin, float* x, const bf16_t* y, const float* wpost, float scale, const float* wpre, bf16_t* h) {
    const int tid = opaque_tid(), lane = tid & 63, wid = tid >> 6, sub = lane >> 4, l16 = lane & 15;
    for (int row = (blockIdx.x * 8 + wid) * 4 + sub; row < MTOK; row += gridDim.x * 32) {
        const size_t ro = (size_t)row * DM + l16 * 4;
        f32x4 xv[16];
        if (MODE == 0 || MODE == 3) {
#pragma unroll
            for (int i = 0; i < 16; ++i) xv[i] = *(const f32x4*)(xin + ro + i * 64);
        } else {
            f32x4 yv[16]; float ss = 0.f;
#pragma unroll
            for (int i = 0; i < 16; ++i) { const u32x2 yw = *(const u32x2*)(y + ro + i * 64); yv[i] = (f32x4){bf_lo(yw.x), bf_hi(yw.x), bf_lo(yw.y), bf_hi(yw.y)}; xv[i] = *(const f32x4*)(x + ro + i * 64); }
#pragma unroll
            for (int i = 0; i < 16; ++i) ss += yv[i][0] * yv[i][0] + yv[i][1] * yv[i][1] + yv[i][2] * yv[i][2] + yv[i][3] * yv[i][3];
            ss = sum16(ss); const float rs = scale * __builtin_amdgcn_rsqf(ss * (1.0f / DM) + EPS);
#pragma unroll
            for (int i = 0; i < 16; ++i) { const f32x4 w = *(const f32x4*)(wpost + l16 * 4 + i * 64); xv[i] += yv[i] * rs * w; }
        }
        if (MODE != 3) {
#pragma unroll
            for (int i = 0; i < 16; ++i) *(f32x4*)(x + ro + i * 64) = xv[i]; }
        if (MODE != 2) {
            float ss = 0.f;
#pragma unroll
            for (int i = 0; i < 16; ++i) ss += xv[i][0] * xv[i][0] + xv[i][1] * xv[i][1] + xv[i][2] * xv[i][2] + xv[i][3] * xv[i][3];
            ss = sum16(ss); const float rs = __builtin_amdgcn_rsqf(ss * (1.0f / DM) + EPS);
#pragma unroll
            for (int i = 0; i < 16; ++i) { const f32x4 w = *(const f32x4*)(wpre + l16 * 4 + i * 64); const f32x4 v = xv[i] * rs * w;
                u32x2 o; o.x = pk_bf16(v[0], v[1]); o.y = pk_bf16(v[2], v[3]); *(u32x2*)(h + ro + i * 64) = o; }
        }
    }
}

__device__ __forceinline__ void ld8(const bf16_t* p, float (&v)[8]) { const u32x4 w = *(const u32x4*)p; v[0] = bf_lo(w.x); v[1] = bf_hi(w.x); v[2] = bf_lo(w.y); v[3] = bf_hi(w.y); v[4] = bf_lo(w.z); v[5] = bf_hi(w.z); v[6] = bf_lo(w.w); v[7] = bf_hi(w.w); }
__device__ __forceinline__ void conv_phase(const bf16_t* tb, const bf16_t* bb, const float* cw, bf16_t* cb) {
    for (int item = blockIdx.x * NTHR + opaque_tid(); item < 262144; item += gridDim.x * NTHR) {
        const int cgp = item & 127, chunk = item >> 7, c0 = cgp * 8, tok0 = chunk * 8, s0 = tok0 & (SEQ - 1);
        u32x4 tr[10], br[8];
        const u32x4 z4 = {0u, 0u, 0u, 0u};
#pragma unroll
        for (int i = 0; i < 10; ++i) { const int s = s0 - 1 + i; const bool ok = (s >= 0) && (s < SEQ); tr[i] = ok ? *(const u32x4*)(tb + (size_t)(tok0 - 1 + i) * DM + c0) : z4; }
#pragma unroll
        for (int i = 0; i < 8; ++i) br[i] = *(const u32x4*)(bb + (size_t)(tok0 + i) * DM + c0);
        float w0[8], w1[8], w2[8];
#pragma unroll
        for (int j = 0; j < 8; ++j) { w0[j] = cw[c0 + j]; w1[j] = cw[1024 + c0 + j]; w2[j] = cw[2048 + c0 + j]; }
        float tp[8], tc[8], tn[8];
#define CONV_T(dst, i) do { const u32x4 a_ = tr[i]; dst[0] = bf_lo(a_.x); dst[1] = bf_hi(a_.x); dst[2] = bf_lo(a_.y); dst[3] = bf_hi(a_.y); dst[4] = bf_lo(a_.z); dst[5] = bf_hi(a_.z); dst[6] = bf_lo(a_.w); dst[7] = bf_hi(a_.w); } while (0)
        CONV_T(tp, 0); CONV_T(tc, 1);
#pragma unroll
        for (int i = 0; i < 8; ++i) {
            CONV_T(tn, i + 2);
            const u32x4 bw = br[i]; const float bv[8] = {bf_lo(bw.x), bf_hi(bw.x), bf_lo(bw.y), bf_hi(bw.y), bf_lo(bw.z), bf_hi(bw.z), bf_lo(bw.w), bf_hi(bw.w)};
            float o[8];
#pragma unroll
            for (int j = 0; j < 8; ++j) { o[j] = bv[j] * (w0[j] * tp[j] + w1[j] * tc[j] + w2[j] * tn[j]); tp[j] = tc[j]; tc[j] = tn[j]; }
            u32x4 w; w.x = pk_bf16(o[0], o[1]); w.y = pk_bf16(o[2], o[3]); w.z = pk_bf16(o[4], o[5]); w.w = pk_bf16(o[6], o[7]);
            *(u32x4*)(cb + (size_t)(tok0 + i) * DM + c0) = w;
        }
#undef CONV_T
    }
}

#ifndef ATT_SCHED
#define ATT_SCHED 0
#endif
__device__ __forceinline__ float fmax3(float a, float b, float c) { return fmaxf(fmaxf(a, b), c); }
__device__ __forceinline__ void attn_phase(LAS unsigned char* lds, const bf16_t* qk, const bf16_t* vt, bf16_t* ob, const float* lv, const float* subln, float lam_init, int vcb) {
    const int tid = opaque_tid(), wid = __builtin_amdgcn_readfirstlane(tid >> 6), lane = tid & 63, r = lane & 31, hf = lane >> 5;
    const int c = wid >> 2, qw = wid & 3;
    float d1 = 0.f, d2 = 0.f;
    for (int i = 0; i < 64; ++i) { d1 += lv[i] * lv[64 + i]; d2 += lv[128 + i] * lv[192 + i]; }
    const float lam = expf(d1) - expf(d2) + lam_init;
    const float C2 = 0.125f * 1.44269504f;
    const int G = gridDim.x, cb = vcb;
    const int pr = (r & ~12) | ((r & 4) << 1) | ((r & 8) >> 1);
    const int ksw = (pr >> 1) & 7, vsw = (r >> 1) & 7;
    const int srow = tid >> 3, sch = tid & 7;
    for (int it = 0;; ++it) {
        const int u = it * G + cb; if (u >= 1024) break;
        int bh, qb;
        if (G == 256) { bh = it * 16 + (cb & 7) * 2 + (cb >> 7); qb = (cb >> 3) & 15; } else { bh = u >> 4; qb = u & 15; }
        const int b = bh >> 3, h = bh & 7;
        const size_t tok0 = (size_t)b * SEQ;
        const size_t qtok = tok0 + qb * 128 + qw * 32 + r;
        const bf16_t* qrow = qk + qtok * QK_LD + h * 128 + c * 64 + 8 * hf;
        bf16x8 Qf[4];
#pragma unroll
        for (int kk = 0; kk < 4; ++kk) Qf[kk] = *(const bf16x8*)(qrow + 16 * kk);
        f32x16 O[4];
#pragma unroll
        for (int d = 0; d < 4; ++d)
#pragma unroll
            for (int i = 0; i < 16; ++i) O[d][i] = 0.f;
        float mrun = -1e30f, lrun = 0.f;
        const int gch = sch ^ ((srow >> 1) & 7);
        const bf16_t* kg = qk + (tok0 + srow) * QK_LD + 1024 + h * 128 + gch * 8;
        const bf16_t* vg = vt + (size_t)(h * 128 + srow) * VT_LD + tok0 + gch * 8;
#define ATT_ISSUE(t) do { const int tt_ = ((t) + 2 * qb) & 31; LAS unsigned char* bs = lds + ((t) & 3) * 32768 + wid * 1024; \
            __builtin_amdgcn_global_load_lds((const unsigned*)(kg + (size_t)tt_ * 64 * QK_LD), (LAS unsigned*)(bs), 16, 0, 0); \
            __builtin_amdgcn_global_load_lds((const unsigned*)(kg + (size_t)tt_ * 64 * QK_LD + 64), (LAS unsigned*)(bs + 8192), 16, 0, 0); \
            __builtin_amdgcn_global_load_lds((const unsigned*)(vg + tt_ * 64), (LAS unsigned*)(bs + 16384), 16, 0, 0); \
            __builtin_amdgcn_global_load_lds((const unsigned*)(vg + tt_ * 64 + (size_t)64 * VT_LD), (LAS unsigned*)(bs + 24576), 16, 0, 0); } while (0)
#define ATT_KLD(buf) do { const LAS unsigned char* kb_ = lds + (buf) * 32768 + c * 8192 + pr * 128; \
            _Pragma("unroll") for (int kk = 0; kk < 4; ++kk) { const int off = ((2 * kk + hf) ^ ksw) << 4; Kf[kk] = *(const LAS bf16x8*)(kb_ + off); Kf[4 + kk] = *(const LAS bf16x8*)(kb_ + 32 * 128 + off); } } while (0)
#define ATT_QKM(D0, D1) do { _Pragma("unroll") for (int i = 0; i < 16; ++i) { D0[i] = 0.f; D1[i] = 0.f; } \
            _Pragma("unroll") for (int kk = 0; kk < 4; ++kk) { D0 = __builtin_amdgcn_mfma_f32_32x32x16_bf16(Kf[kk], Qf[kk], D0, 0, 0, 0); D1 = __builtin_amdgcn_mfma_f32_32x32x16_bf16(Kf[4 + kk], Qf[kk], D1, 0, 0, 0); } } while (0)
#define ATT_VLD(DST, buf, d0) do { const LAS unsigned char* vb_ = lds + (buf) * 32768 + 16384 + r * 128; \
            _Pragma("unroll") for (int dd = 0; dd < 2; ++dd) _Pragma("unroll") for (int kb = 0; kb < 2; ++kb) _Pragma("unroll") for (int s = 0; s < 2; ++s) \
                DST[dd * 4 + kb * 2 + s] = *(const LAS bf16x8*)(vb_ + ((d0) + dd) * 32 * 128 + (((4 * kb + 2 * s + hf) ^ vsw) << 4)); } while (0)
#define ATT_PVM(SRC, d0) do { _Pragma("unroll") for (int kb = 0; kb < 2; ++kb) _Pragma("unroll") for (int s = 0; s < 2; ++s) _Pragma("unroll") for (int dd = 0; dd < 2; ++dd) \
                O[(d0) + dd] = __builtin_amdgcn_mfma_f32_32x32x16_bf16(SRC[dd * 4 + kb * 2 + s], P[kb][s], O[(d0) + dd], 0, 0, 0); } while (0)
#define ATT_BAR() do { asm volatile("" ::: "memory"); __builtin_amdgcn_s_barrier(); asm volatile("" ::: "memory"); } while (0)
#define ATT_SB() __builtin_amdgcn_sched_barrier(0)
        ATT_ISSUE(0); ATT_ISSUE(1); if (c == 0) ATT_ISSUE(2);
        asm volatile("s_waitcnt vmcnt(0)" ::: "memory"); ATT_BAR();
        f32x16 S0, S1;
        bf16x8 Kf[8], VA[8];
        bf16x8 P[2][2];
        ATT_KLD(0); ATT_QKM(S0, S1);
#define ATT_PV(buf) do { ATT_VLD(VA, (buf), 0); ATT_SB(); ATT_PVM(VA, 0); ATT_SB(); ATT_VLD(VA, (buf), 2); ATT_SB(); ATT_PVM(VA, 2); ATT_SB(); } while (0)
        for (int t = 0; t < 32; ++t) {
            if (c == 1 && t < 30) ATT_ISSUE(t + 2);
            if (t > 0) ATT_PV((t - 1) & 3);
            if (c == 0) { asm volatile("s_waitcnt vmcnt(0)" ::: "memory"); ATT_BAR(); if (t < 29) ATT_ISSUE(t + 3); }
            ATT_KLD((t + 1) & 3);
            ATT_SB();
            float tm = fmaxf(S0[0], S1[0]);
#pragma unroll
            for (int i = 1; i < 16; ++i) tm = fmax3(tm, S0[i], S1[i]);
            tm = fmaxf(tm, __shfl_xor(tm, 32));
            const bool upd = tm > mrun + 64.0f;
            const float mn = upd ? tm : mrun, alpha = __builtin_amdgcn_exp2f((mrun - mn) * C2), mc = mn * C2;
            mrun = mn;
            if (__builtin_amdgcn_ballot_w64(upd) != 0ull) {
#pragma unroll
                for (int d = 0; d < 4; ++d)
#pragma unroll
                    for (int i = 0; i < 16; ++i) O[d][i] *= alpha;
            }
            ATT_SB();
            f32x16 N0, N1;
            ATT_QKM(N0, N1);
            float rs = 0.f;
#pragma unroll
            for (int i = 0; i < 16; ++i) { S0[i] = __builtin_amdgcn_exp2f(S0[i] * C2 - mc); S1[i] = __builtin_amdgcn_exp2f(S1[i] * C2 - mc); rs += S0[i] + S1[i]; }
            lrun = lrun * alpha + rs;
#pragma unroll
            for (int s = 0; s < 2; ++s) {
                u32x4 w0, w1;
                w0.x = pk_bf16(S0[8 * s + 0], S0[8 * s + 1]); w0.y = pk_bf16(S0[8 * s + 2], S0[8 * s + 3]); w0.z = pk_bf16(S0[8 * s + 4], S0[8 * s + 5]); w0.w = pk_bf16(S0[8 * s + 6], S0[8 * s + 7]);
                w1.x = pk_bf16(S1[8 * s + 0], S1[8 * s + 1]); w1.y = pk_bf16(S1[8 * s + 2], S1[8 * s + 3]); w1.z = pk_bf16(S1[8 * s + 4], S1[8 * s + 5]); w1.w = pk_bf16(S1[8 * s + 6], S1[8 * s + 7]);
                P[0][s] = __builtin_bit_cast(bf16x8, w0); P[1][s] = __builtin_bit_cast(bf16x8, w1);
            }
            ATT_SB();
            if (c == 1) { asm volatile("s_waitcnt vmcnt(0)" ::: "memory"); ATT_BAR(); }
            S0 = N0; S1 = N1;
        }
        ATT_PV(31 & 3);
#undef ATT_PV
#undef ATT_KLD
#undef ATT_QKM
#undef ATT_VLD
#undef ATT_PVM
#undef ATT_ISSUE
        const float lt = lrun + __shfl_xor(lrun, 32);
        LAS float* X = (LAS float*)lds + qw * 4096 + lane;
        if (c == 1) { const float sc = lam / lt;
#pragma unroll
            for (int d = 0; d < 4; ++d)
#pragma unroll
                for (int i = 0; i < 16; ++i) X[(d * 16 + i) * 64] = O[d][i] * sc; }
        __syncthreads();
        if (c == 0) { const float sc = 1.0f / lt; float ss = 0.f;
#pragma unroll
            for (int d = 0; d < 4; ++d)
#pragma unroll
                for (int i = 0; i < 16; ++i) { const float o = O[d][i] * sc - X[(d * 16 + i) * 64]; O[d][i] = o; ss += o * o; }
            ss += __shfl_xor(ss, 32);
            const float rms = __builtin_amdgcn_rsqf(ss * (1.0f / 128.0f) + EPS) * (1.0f - lam_init);
            bf16_t* orow = ob + qtok * DM + h * 128 + 4 * hf;
#pragma unroll
            for (int d = 0; d < 4; ++d)
#pragma unroll
                for (int g = 0; g < 4; ++g) { const int dv = 32 * d + 8 * g;
                    const f32x4 w = *(const f32x4*)(subln + dv + 4 * hf);
                    u32x2 o; o.x = pk_bf16(O[d][4 * g] * rms * w[0], O[d][4 * g + 1] * rms * w[1]); o.y = pk_bf16(O[d][4 * g + 2] * rms * w[2], O[d][4 * g + 3] * rms * w[3]);
                    *(u32x2*)(orow + dv) = o; } }
        __syncthreads();
    }
}
#define XB_TMO      128
#define XB_XCNT(j)  (256  + 64 * (j))
#define XB_XSUB(j)  (1280 + 64 * (j))
#define XB_XGEN(j)  (2304 + 64 * (j))
#define XB_TOP      3328
#define XB_TOPGEN   3392
#define XCD_BAR_WORDS 3456
#define XB_SPIN_CAP (1u << 18)

__device__ __forceinline__ unsigned xb_ld(unsigned* p)              { return __hip_atomic_load(p, __ATOMIC_RELAXED, __HIP_MEMORY_SCOPE_AGENT); }
__device__ __forceinline__ unsigned xb_add(unsigned* p, unsigned v) { return __hip_atomic_fetch_add(p, v, __ATOMIC_RELAXED, __HIP_MEMORY_SCOPE_AGENT); }
__device__ __forceinline__ unsigned xb_xcc_id() { return (unsigned)__builtin_amdgcn_s_getreg((3 << 11) | 20) & 0xFu; }
#define XB_SPIN(cond, bar) do { unsigned _sp = 0; while (cond) { __builtin_amdgcn_s_sleep(1); \
    if ((++_sp & 255u) == 0u) { if (xb_ld(&(bar)[XB_TMO])) break; if (_sp > XB_SPIN_CAP) { atomicAdd(&(bar)[XB_TMO], 1u); break; } } } } while (0)

struct XcdBarrier {
    unsigned* bar; unsigned x;
    volatile LAS unsigned* st;
};

__device__ __forceinline__ XcdBarrier xcd_barrier_post(unsigned* bar, volatile LAS unsigned* st) {
    XcdBarrier b; b.bar = bar; b.x = xb_xcc_id(); b.st = st;
    if (threadIdx.x == 0) (void)xb_add(&bar[XB_XCNT(b.x)], 1u);
    return b;
}
__device__ __forceinline__ void xcd_barrier_complete(unsigned* bar, unsigned x, unsigned& nloc, unsigned& nx) {
    const unsigned G = gridDim.x * gridDim.y * gridDim.z;
    unsigned sum, cnt, mine, sp = 0u;
    for (;;) {
        sum = 0u; cnt = 0u; mine = 0u;
#pragma unroll
        for (unsigned j = 0; j < 16; ++j) { const unsigned c = xb_ld(&bar[XB_XCNT(j)]); sum += c; cnt += (c > 0u) ? 1u : 0u; mine = (j == x) ? c : mine; }
        if (sum == G) break;
        __builtin_amdgcn_s_sleep(1);
        if ((++sp & 255u) == 0u) { if (xb_ld(&bar[XB_TMO])) break; if (sp > XB_SPIN_CAP) { atomicAdd(&bar[XB_TMO], 1u); break; } }
    }
    nloc = mine > 0u ? mine : 1u; nx = cnt > 0u ? cnt : 1u;
}

__device__ __forceinline__ void xcd_barrier(const XcdBarrier& b) {
    asm volatile("s_waitcnt vmcnt(0)" ::: "memory");
    __syncthreads();
    if (threadIdx.x == 0) {
        unsigned* bar = b.bar;
        __builtin_amdgcn_s_waitcnt(0);
        unsigned nloc = b.st[0], nx = b.st[1];
        if (nloc == 0u) { xcd_barrier_complete(bar, b.x, nloc, nx); b.st[0] = nloc; b.st[1] = nx; }
        const unsigned old = xb_add(&bar[XB_XSUB(b.x)], 1u);
        const unsigned gen = old / nloc;
        if (old + 1u == (gen + 1u) * nloc) {
            __builtin_amdgcn_fence(__ATOMIC_RELEASE, "agent");
            asm volatile("s_waitcnt vmcnt(0)" ::: "memory");
            const unsigned og = xb_add(&bar[XB_TOP], 1u);
            const unsigned tg = og / nx;
            if (og + 1u == (tg + 1u) * nx) xb_add(&bar[XB_TOPGEN], 1u);
            else XB_SPIN(xb_ld(&bar[XB_TOPGEN]) == tg, bar);
            __builtin_amdgcn_fence(__ATOMIC_ACQUIRE, "agent");
            xb_add(&bar[XB_XGEN(b.x)], 1u);
            asm volatile("s_waitcnt vmcnt(0)" ::: "memory");
        } else {
            XB_SPIN(xb_ld(&bar[XB_XGEN(b.x)]) == gen, bar);
            __builtin_amdgcn_fence(__ATOMIC_ACQUIRE, "agent");
            asm volatile("s_waitcnt vmcnt(0)" ::: "memory");
        }
    }
    __syncthreads();
}
#ifndef REP_GEMM
#define REP_GEMM 1
#endif
#ifndef REP_ATTN
#define REP_ATTN 1
#endif
#ifndef REP_CONV
#define REP_CONV 1
#endif
#ifndef REP_CVT
#define REP_CVT 1
#endif
#ifndef REP_SYNC
#define REP_SYNC 1
#endif
#define GSYNC() do { for (int rep_ = 0; rep_ < REP_SYNC; ++rep_) xcd_barrier(bar); } while (0)
template <class Epi> __device__ __forceinline__ void run_gemm_(LAS unsigned char* lds, const bf16_t* A, const bf16_t* Bt, int M, int N, int K, const Epi& E, int vcb) {
    pg8::Gemm g{A, Bt, M, N, K}; pg8::StaticOrder S; S.init(M, N, (int)gridDim.x, vcb);
    for (int rep = 0; rep < REP_GEMM; ++rep) pg8::gemm_phase<Epi, pg8::StaticOrder, false>(lds, g, S, E, nullptr);
}

typedef const __attribute__((address_space(4))) Params* KPtr;
__device__ __forceinline__ KPtr kparams() { KPtr kp = (KPtr)__builtin_amdgcn_kernarg_segment_ptr(); asm volatile("" : "+s"(kp)); return kp; }
#define WSP(T, off) ((T*)(kparams()->ws + (off)))
#define VCB() ((int)__builtin_amdgcn_readfirstlane(((volatile LAS unsigned*)(lds + 131072))[2]))
#define run_gemm(...) run_gemm_(__VA_ARGS__, VCB())
template <bool fusedn> __global__ void __launch_bounds__(NTHR) fwd_megakernel(Params p_unused) {
    extern __shared__ __attribute__((aligned(16))) unsigned char smem[];
    cg::grid_group grid = cg::this_grid();
    LAS unsigned char* lds = (LAS unsigned char*)smem;
    if (threadIdx.x < 4) ((LAS unsigned*)(lds + 131072))[threadIdx.x] = 0u;
    __syncthreads();
    const XcdBarrier bar = xcd_barrier_post(WSP(unsigned, OFF_BAR), (volatile LAS unsigned*)(lds + 131072));
    if (threadIdx.x == 0) { unsigned* cen = WSP(unsigned, OFF_CEN); ((volatile LAS unsigned*)(lds + 131072))[3] = __hip_atomic_fetch_add(cen + 64 * bar.x, 1u, __ATOMIC_RELAXED, __HIP_MEMORY_SCOPE_AGENT); }

    { const KPtr kp = kparams(); for (int rep = 0; rep < REP_CVT; ++rep) convert_weights(kp, 0, 0, 528, (int)blockIdx.x, (int)gridDim.x); }
    rope_tables(WSP(float, OFF_TAB), WSP(float, OFF_TAB) + SEQ * 8);
    { const KPtr kp = kparams(); if constexpr (fusedn) row_phase<3>(kp->x, nullptr, nullptr, nullptr, 0.f, kp->norm_w, WSP(bf16_t, OFF_HB)); else row_phase<0>(kp->x, kp->out, nullptr, nullptr, 0.f, kp->norm_w, WSP(bf16_t, OFF_HB)); }
    grid.sync();
    if (threadIdx.x == 0) { unsigned* cen = WSP(unsigned, OFF_CEN); const unsigned per = gridDim.x >> 3; bool ok = (gridDim.x & 7u) == 0u && bar.x < 8u;
        for (int j = 0; j < 8; ++j) ok = ok && (__hip_atomic_load(cen + 64 * j, __ATOMIC_RELAXED, __HIP_MEMORY_SCOPE_AGENT) == per);
        volatile LAS unsigned* w = (volatile LAS unsigned*)(lds + 131072); w[2] = ok ? (w[3] * 8u + bar.x) : blockIdx.x; }
    __syncthreads();
    for (int l = 0; l < 2; ++l) {
        run_gemm(lds, WSP(bf16_t, OFF_HB), WSP(bf16_t, OFF_W13A), MTOK, 2 * DFF, DM, pg8::EpiGlu<true>{WSP(bf16_t, OFF_AB), DFF});
        { const int rem = 1408 % (int)gridDim.x, vc = VCB(); const KPtr kp = kparams();
          if (rem == 0) convert_weights(kp, l, 528, 1760, vc, (int)gridDim.x); else if (vc >= rem) convert_weights(kp, l, 528, 1760, vc - rem, (int)gridDim.x - rem); }
        GSYNC();
        if constexpr (fusedn) { const KPtr kp = kparams(); const float* nw = kp->norm_w + (size_t)l * 6 * DM;
            run_gemm(lds, WSP(bf16_t, OFF_AB), WSP(bf16_t, OFF_W2A), MTOK, DM, DFF, pg8::EpiNormRes{l == 0 ? kp->x : kp->out, kp->out, nw + DM, 0.5f, nw + 2 * DM, WSP(bf16_t, OFF_HB), WSP(float, OFF_SLOT), WSP(unsigned, OFF_CNT), (unsigned)(l * 6)}); }
        else { run_gemm(lds, WSP(bf16_t, OFF_AB), WSP(bf16_t, OFF_W2A), MTOK, DM, DFF, pg8::EpiBf16{WSP(bf16_t, OFF_YF1), DM, 0, nullptr, 0, nullptr, nullptr, 0}); GSYNC();
            const KPtr kp = kparams(); const float* nw = kp->norm_w + (size_t)l * 6 * DM; row_phase<1>(nullptr, kp->out, WSP(bf16_t, OFF_YF1), nw + DM, 0.5f, nw + 2 * DM, WSP(bf16_t, OFF_HB)); }
        GSYNC();
        run_gemm(lds, WSP(bf16_t, OFF_HB), WSP(bf16_t, OFF_WIN), MTOK, 2048, DM, pg8::EpiGlu<false>{WSP(bf16_t, OFF_TCH), DM});
        run_gemm(lds, WSP(bf16_t, OFF_HB), WSP(bf16_t, OFF_WIN) + (size_t)2048 * DM, MTOK, 1024, DM, pg8::EpiBf16{WSP(bf16_t, OFF_BB), DM, 0, nullptr, 0, nullptr, nullptr, 0});
        GSYNC();
        for (int rep = 0; rep < REP_CONV; ++rep) conv_phase(WSP(bf16_t, OFF_TCH), WSP(bf16_t, OFF_BB), kparams()->conv_w + (size_t)l * 3 * DM, WSP(bf16_t, OFF_CB));
        GSYNC();
        run_gemm(lds, WSP(bf16_t, OFF_HB), WSP(bf16_t, OFF_WIN) + (size_t)3072 * DM, MTOK, 4096, DM, pg8::EpiBf16{WSP(bf16_t, OFF_QK), QK_LD, 8, WSP(bf16_t, OFF_GL), 8, WSP(float, OFF_TAB), WSP(float, OFF_TAB) + SEQ * 8, 2048});
        run_gemm(lds, WSP(bf16_t, OFF_WIN) + (size_t)7168 * DM, WSP(bf16_t, OFF_HB), DM, MTOK, DM, pg8::EpiBf16{WSP(bf16_t, OFF_VT), VT_LD, 0, nullptr, 0, nullptr, nullptr, 0});
        GSYNC();
        { const KPtr kp = kparams(); const float lam_init = 0.8f - 0.6f * expf(-0.3f * (float)l);
          for (int rep = 0; rep < REP_ATTN; ++rep) attn_phase(lds, WSP(bf16_t, OFF_QK), WSP(bf16_t, OFF_VT), WSP(bf16_t, OFF_OB), kp->lam_vec + (size_t)l * 256, kp->subln_w + (size_t)l * 128, lam_init, VCB()); }
        GSYNC();
        run_gemm(lds, WSP(bf16_t, OFF_CB), WSP(bf16_t, OFF_WCO), MTOK, DM, DM, pg8::EpiGate<1>{WSP(bf16_t, OFF_GL), 2048, kparams()->b_gate + (size_t)l * 2048, WSP(bf16_t, OFF_M1), WSP(bf16_t, OFF_MB), DM});
        run_gemm(lds, WSP(bf16_t, OFF_OB), WSP(bf16_t, OFF_WAO), MTOK, DM, DM, pg8::EpiGate<2>{WSP(bf16_t, OFF_GL) + 1024, 2048, kparams()->b_gate + (size_t)l * 2048 + 1024, WSP(bf16_t, OFF_M1), WSP(bf16_t, OFF_MB), DM});
        GSYNC();
        if constexpr (fusedn) { const KPtr kp = kparams(); const float* nw = kp->norm_w + (size_t)l * 6 * DM;
            run_gemm(lds, WSP(bf16_t, OFF_MB), WSP(bf16_t, OFF_WO), MTOK, DM, DM, pg8::EpiNormRes{kp->out, kp->out, nw + 3 * DM, 1.0f, nw + 4 * DM, WSP(bf16_t, OFF_HB), WSP(float, OFF_SLOT), WSP(unsigned, OFF_CNT), (unsigned)(l * 6 + 2)}); }
        else { run_gemm(lds, WSP(bf16_t, OFF_MB), WSP(bf16_t, OFF_WO), MTOK, DM, DM, pg8::EpiBf16{WSP(bf16_t, OFF_YF2), DM, 0, nullptr, 0, nullptr, nullptr, 0}); GSYNC();
            const KPtr kp = kparams(); const float* nw = kp->norm_w + (size_t)l * 6 * DM; row_phase<1>(nullptr, kp->out, WSP(bf16_t, OFF_YF2), nw + 3 * DM, 1.0f, nw + 4 * DM, WSP(bf16_t, OFF_HB)); }
        GSYNC();
        run_gemm(lds, WSP(bf16_t, OFF_HB), WSP(bf16_t, OFF_W13B), MTOK, 2 * DFF, DM, pg8::EpiGlu<true>{WSP(bf16_t, OFF_AB), DFF});
        if (l == 0) { const int rem = 1408 % (int)gridDim.x, vc = VCB(); const KPtr kp = kparams();
          if (rem == 0) convert_weights(kp, 1, 0, 528, vc, (int)gridDim.x); else if (vc >= rem) convert_weights(kp, 1, 0, 528, vc - rem, (int)gridDim.x - rem); }
        GSYNC();
        if constexpr (fusedn) { const KPtr kp = kparams(); const float* nw = kp->norm_w + (size_t)l * 6 * DM;
            run_gemm(lds, WSP(bf16_t, OFF_AB), WSP(bf16_t, OFF_W2B), MTOK, DM, DFF, pg8::EpiNormRes{kp->out, kp->out, nw + 5 * DM, 0.5f, nw + 6 * DM, l == 0 ? WSP(bf16_t, OFF_HB) : nullptr, WSP(float, OFF_SLOT), WSP(unsigned, OFF_CNT), (unsigned)(l * 6 + 4)}); }
        else { run_gemm(lds, WSP(bf16_t, OFF_AB), WSP(bf16_t, OFF_W2B), MTOK, DM, DFF, pg8::EpiBf16{WSP(bf16_t, OFF_YF1), DM, 0, nullptr, 0, nullptr, nullptr, 0}); GSYNC();
            const KPtr kp = kparams(); const float* nw = kp->norm_w + (size_t)l * 6 * DM;
            if (l == 0) row_phase<1>(nullptr, kp->out, WSP(bf16_t, OFF_YF1), nw + 5 * DM, 0.5f, nw + 6 * DM, WSP(bf16_t, OFF_HB));
            else row_phase<2>(nullptr, kp->out, WSP(bf16_t, OFF_YF1), nw + 5 * DM, 0.5f, nullptr, nullptr); }
        if (l == 0) GSYNC();
    }
}

extern "C" void kernel_launch(void* const* d_in, const int* in_sizes, int n_in, void* d_out, int out_size, void* d_ws, size_t ws_size, hipStream_t stream) {
    static int grid_blocks = 0; static const void* kfn = nullptr;
    if (grid_blocks == 0) {
        if (ws_size < WS_NEED) { fprintf(stderr, "kernel_launch: workspace too small: %zu < %zu\n", ws_size, (size_t)WS_NEED); grid_blocks = -1; return; }
        int dev = 0, cus = 0, per_cu = 0;
        (void)hipGetDevice(&dev);
        (void)hipDeviceGetAttribute(&cus, hipDeviceAttributeMultiprocessorCount, dev);
        kfn = (cus == 256) ? (const void*)fwd_megakernel<true> : (const void*)fwd_megakernel<false>;
        if (hipFuncSetAttribute((const void*)kfn, hipFuncAttributeMaxDynamicSharedMemorySize, LDS_BYTES) != hipSuccess) { fprintf(stderr, "kernel_launch: hipFuncSetAttribute failed\n"); grid_blocks = -1; return; }
        if (hipOccupancyMaxActiveBlocksPerMultiprocessor(&per_cu, (const void*)kfn, NTHR, LDS_BYTES) != hipSuccess || per_cu < 1) { fprintf(stderr, "kernel_launch: occupancy query failed (%d)\n", per_cu); grid_blocks = -1; return; }
        grid_blocks = cus * 1;
        fprintf(stderr, "kernel_launch: cus %d per_cu %d grid %d ws %zu\n", cus, per_cu, grid_blocks, ws_size);
    }
    if (grid_blocks < 0) return;
    if (hipMemsetAsync((char*)d_ws + OFF_BAR, 0, 32768 + 4096, stream) != hipSuccess) { fprintf(stderr, "kernel_launch: memset failed\n"); return; }
    Params p{};
    p.x = (const float*)d_in[0]; p.w_in = (const float*)d_in[1]; p.b_gate = (const float*)d_in[2]; p.conv_w = (const float*)d_in[3]; p.w_conv_out = (const float*)d_in[4];
    p.w_attn_out = (const float*)d_in[5]; p.lam_vec = (const float*)d_in[6]; p.subln_w = (const float*)d_in[7]; p.w_o = (const float*)d_in[8];
    p.ffn1_w13 = (const float*)d_in[9]; p.ffn1_w2 = (const float*)d_in[10]; p.ffn2_w13 = (const float*)d_in[11]; p.ffn2_w2 = (const float*)d_in[12]; p.norm_w = (const float*)d_in[13];
    p.out = (float*)d_out; p.ws = (unsigned char*)d_ws;
    void* args[] = {&p};
    hipError_t e = hipLaunchCooperativeKernel((const void*)kfn, dim3(grid_blocks), dim3(NTHR), args, LDS_BYTES, stream);
    if (e != hipSuccess) fprintf(stderr, "cooperative launch failed: %s (grid %d)\n", hipGetErrorString(e), grid_blocks);
}
```

```cpp
#include <hip/hip_runtime.h>
#include <hip/hip_cooperative_groups.h>
#include <cstdio>
namespace cg = cooperative_groups;
__device__ __forceinline__ int opaque_tid() { int t = threadIdx.x; asm volatile("" : "+v"(t)); return t; }
namespace pg8 {
#define PG8_LAS __attribute__((address_space(3)))
typedef unsigned short bf16_t;
typedef short bf16x8 __attribute__((ext_vector_type(8)));
typedef float f32x4 __attribute__((ext_vector_type(4)));
typedef unsigned u32x4 __attribute__((ext_vector_type(4)));
constexpr int BM = 256, BK = 64, HALF = 128, HTB = HALF * BK * 2  , STAGE_BYTES = 8 * HTB, NXCD = 8, WGM = 8;

__host__ __device__ __forceinline__ int lds_byte(int r, int c) { const int st = (r >> 4) * 2 + (c >> 5), rr = r & 15, cc = c & 31, ob = rr * 64 + cc * 2; return st * 1024 + (ob ^ (((ob >> 9) & 1) << 5)); }
__host__ __device__ __forceinline__ void stage_rc(int b, int& R, int& C) { const int st = b / 1024, sb = b % 1024, swz = sb ^ (((sb >> 9) & 1) << 5); R = (st >> 1) * 16 + swz / 64; C = (st & 1) * 32 + (swz % 64) / 2; }
__host__ __device__ __forceinline__ int perm32(int rho) { const int n = rho >> 4, i = rho & 15; return 8 * (i >> 2) + 4 * n + (i & 3); }

struct Unit { int pm, pn; };
struct Gemm { const bf16_t* A; const bf16_t* Bt; int M, N, K; };

struct StaticOrder {
    int nM, nN, nwg, G, c;
    __host__ __device__ void init(int M, int N, int G_, int c_) { nM = M / BM; nN = N / BM; nwg = nM * nN; G = G_; c = c_; }
    __host__ __device__ bool next(int i, Unit& u) const {
        const long L = (long)i * G + c; if (L >= nwg) return false;
        int wgid = (int)L; { const int q = nwg / NXCD, r = nwg % NXCD, xcd = wgid % NXCD, off = wgid / NXCD; wgid = (xcd < r ? xcd * (q + 1) : r * (q + 1) + (xcd - r) * q) + off; }
        const int nig = WGM * nN, gid = wgid / nig, fm = gid * WGM, gsz = (nM - fm) < WGM ? (nM - fm) : WGM;
        u.pm = fm + ((wgid % nig) % gsz); u.pn = (wgid % nig) / gsz; return true;
    }
    __device__ __forceinline__ void a_ready(const Unit&) const {}
    __device__ __forceinline__ void done(const Unit&) const {}
};
template <class Epi, class Sched, bool ALIGN_EPI = false, bool SP2 = false>
__device__ __forceinline__ void gemm_phase(PG8_LAS unsigned char* lds, const Gemm g, const Sched& S, const Epi& E) {
    const int tid = opaque_tid(), wid = __builtin_amdgcn_readfirstlane(tid >> 6), lane = tid & 63, wr = wid >> 2, wc = wid & 3, fr = lane & 15, fq = lane >> 4;
    const int K = g.K, nt = K / BK;
    unsigned voffA[2], voffB[2];
#pragma unroll
    for (int i = 0; i < 2; ++i) { int R, C; stage_rc(tid * 16 + i * 8192, R, C); const int Rb = Epi::PERM ? ((R & ~31) + perm32(R & 31)) : R;
        voffA[i] = (unsigned)(R * K + C) * 2u; voffB[i] = (unsigned)(Rb * K + C) * 2u; }
    const size_t kstep = (size_t)(BK * 2);
    const size_t hstep = (size_t)HALF * K * 2;
    const size_t tstep = 2 * hstep;
    const unsigned ldsw = (unsigned)wid * 1024u;
    const int aoff = lds_byte(wr * 64 + fr, fq * 8), boff = lds_byte(wc * 32 + fr, fq * 8);
#define PG8_SA(b, h) (((b) * 2 + (h)) * HTB)
#define PG8_SB(b, h) ((4 + (b) * 2 + (h)) * HTB)
#define PG8_STAGE(bufoff, gbase, voff) do { _Pragma("unroll") for (int _i = 0; _i < 2; ++_i) \
        __builtin_amdgcn_global_load_lds((const unsigned*)((const char*)(gbase) + (voff)[_i]), (PG8_LAS unsigned*)(lds + (bufoff) + ldsw + _i * 8192), 16, 0, 0); } while (0)
#define PG8_LDA(dst, b, h) do { _Pragma("unroll") for (int m = 0; m < 4; ++m) _Pragma("unroll") for (int k = 0; k < 2; ++k) dst[m][k] = *(const PG8_LAS bf16x8*)(lds + PG8_SA(b, h) + aoff + m * 2048 + k * 1024); } while (0)
#define PG8_LDB(dst, b, h) do { _Pragma("unroll") for (int n = 0; n < 2; ++n) _Pragma("unroll") for (int k = 0; k < 2; ++k) dst[n][k] = *(const PG8_LAS bf16x8*)(lds + PG8_SB(b, h) + boff + n * 2048 + k * 1024); } while (0)
#define PG8_MMA(ai, bj, At, Bt) do { __builtin_amdgcn_s_setprio(1); _Pragma("unroll") for (int m = 0; m < 4; ++m) _Pragma("unroll") for (int n = 0; n < 2; ++n) _Pragma("unroll") for (int k = 0; k < 2; ++k) \
        acc[ai][bj][m][n] = __builtin_amdgcn_mfma_f32_16x16x32_bf16(Bt[n][k], At[m][k], acc[ai][bj][m][n], 0, 0, 0); __builtin_amdgcn_s_setprio(0); } while (0)
#define PG8_WAIT_V(n) asm volatile("s_waitcnt vmcnt(" #n ")" ::: "memory")
#define PG8_WAIT_L(n) asm volatile("s_waitcnt lgkmcnt(" #n ")" ::: "memory")
#define PG8_BAR __builtin_amdgcn_s_barrier()
#define PG8_SCHED __builtin_amdgcn_sched_barrier(0)
    Unit cur, nxt; int ui = 0;
    if (!S.next(0, cur)) return;
    f32x4 acc[2][2][4][2];
#pragma unroll
    for (int a = 0; a < 2; ++a)
#pragma unroll
        for (int b = 0; b < 2; ++b)
#pragma unroll
            for (int m = 0; m < 4; ++m)
#pragma unroll
                for (int n = 0; n < 2; ++n) acc[a][b][m][n] = (f32x4){0.f, 0.f, 0.f, 0.f};
    bf16x8 At[4][2], B0[2][2], B1[2][2];
    const char* cA = (const char*)g.A + (size_t)cur.pm * tstep; const char* cB = (const char*)g.Bt + (size_t)cur.pn * tstep;
    S.a_ready(cur);
    if constexpr (SP2) {
        PG8_STAGE(PG8_SB(0, 0), cB, voffB); PG8_STAGE(PG8_SB(0, 1), cB + hstep, voffB); PG8_STAGE(PG8_SA(0, 0), cA, voffA); PG8_STAGE(PG8_SA(0, 1), cA + hstep, voffA);
        if (wr == 1) PG8_BAR;
        PG8_WAIT_V(2); PG8_BAR;
        PG8_STAGE(PG8_SB(1, 0), cB + kstep, voffB); PG8_STAGE(PG8_SA(1, 0), cA + kstep, voffA); PG8_STAGE(PG8_SB(1, 1), cB + hstep + kstep, voffB);
        PG8_WAIT_V(6); PG8_BAR;
    } else {
        PG8_STAGE(PG8_SB(0, 0), cB, voffB); PG8_STAGE(PG8_SA(0, 0), cA, voffA); PG8_STAGE(PG8_SB(0, 1), cB + hstep, voffB); PG8_STAGE(PG8_SA(0, 1), cA + hstep, voffA);
        if (wr == 1) PG8_BAR;
        PG8_WAIT_V(4); PG8_BAR;
        PG8_STAGE(PG8_SB(1, 0), cB + kstep, voffB); PG8_STAGE(PG8_SA(1, 0), cA + kstep, voffA); PG8_STAGE(PG8_SB(1, 1), cB + hstep + kstep, voffB);
        PG8_WAIT_V(6); PG8_BAR;
    }
    for (;;) {
        const bool has_next = S.next(ui + 1, nxt);
        const char* nA = has_next ? (const char*)g.A + (size_t)nxt.pm * tstep : cA; const char* nB = has_next ? (const char*)g.Bt + (size_t)nxt.pn * tstep : cB;
        for (int t = 0; t < nt; t += 2) {
            const bool last = (t == nt - 2);
            const char* a1 = cA + (size_t)(t + 1) * kstep;
            const char* a2 = last ? nA : cA + (size_t)(t + 2) * kstep; const char* b2 = last ? nB : cB + (size_t)(t + 2) * kstep;
            const char* a3 = a2 + kstep; const char* b3 = b2 + kstep;
            if (last && has_next) S.a_ready(nxt);
            if constexpr (SP2) {
            PG8_LDB(B0, 0, 0); PG8_LDB(B1, 0, 1); PG8_SCHED; PG8_LDA(At, 0, 0); PG8_STAGE(PG8_SA(1, 1), a1 + hstep, voffA);
            PG8_WAIT_V(8); PG8_WAIT_L(0); PG8_BAR; PG8_MMA(0, 0, At, B0); PG8_MMA(0, 1, At, B1); PG8_BAR; PG8_SCHED;
            PG8_LDA(At, 0, 1); PG8_STAGE(PG8_SB(0, 0), b2, voffB); PG8_STAGE(PG8_SB(0, 1), b2 + hstep, voffB); PG8_STAGE(PG8_SA(0, 0), a2, voffA);
            PG8_WAIT_V(8); PG8_WAIT_L(0); PG8_BAR; PG8_MMA(1, 0, At, B0); PG8_MMA(1, 1, At, B1); PG8_BAR; PG8_SCHED;
            PG8_LDB(B0, 1, 0); PG8_LDB(B1, 1, 1); PG8_SCHED; PG8_LDA(At, 1, 0); PG8_STAGE(PG8_SA(0, 1), a2 + hstep, voffA);
            PG8_WAIT_V(8); PG8_WAIT_L(0); PG8_BAR; PG8_MMA(0, 0, At, B0); PG8_MMA(0, 1, At, B1); PG8_BAR; PG8_SCHED;
            PG8_LDA(At, 1, 1); PG8_STAGE(PG8_SB(1, 0), b3, voffB); PG8_STAGE(PG8_SB(1, 1), b3 + hstep, voffB); PG8_STAGE(PG8_SA(1, 0), a3, voffA);
            PG8_WAIT_V(8); PG8_WAIT_L(0); PG8_BAR; PG8_MMA(1, 0, At, B0); PG8_MMA(1, 1, At, B1); PG8_BAR; PG8_SCHED;
            } else {
            PG8_LDB(B0, 0, 0); PG8_SCHED; PG8_LDA(At, 0, 0); PG8_STAGE(PG8_SA(1, 1), a1 + hstep, voffA);
            PG8_WAIT_L(8); PG8_BAR; PG8_WAIT_L(0); PG8_MMA(0, 0, At, B0); PG8_BAR; PG8_SCHED;
            PG8_LDB(B1, 0, 1); PG8_STAGE(PG8_SB(0, 0), b2, voffB);
            PG8_BAR; PG8_WAIT_L(0); PG8_MMA(0, 1, At, B1); PG8_BAR;
            PG8_LDA(At, 0, 1); PG8_STAGE(PG8_SA(0, 0), a2, voffA);
            PG8_BAR; PG8_WAIT_L(0); PG8_MMA(1, 0, At, B0); PG8_BAR; PG8_SCHED;
            PG8_STAGE(PG8_SB(0, 1), b2 + hstep, voffB);
            PG8_WAIT_V(6); PG8_BAR; PG8_MMA(1, 1, At, B1); PG8_BAR;
            PG8_LDB(B0, 1, 0); PG8_SCHED; PG8_LDA(At, 1, 0); PG8_STAGE(PG8_SA(0, 1), a2 + hstep, voffA);
            PG8_WAIT_L(8); PG8_BAR; PG8_WAIT_L(0); PG8_MMA(0, 0, At, B0); PG8_BAR; PG8_SCHED;
            PG8_LDB(B1, 1, 1); PG8_STAGE(PG8_SB(1, 0), b3, voffB);
            PG8_BAR; PG8_WAIT_L(0); PG8_MMA(0, 1, At, B1); PG8_BAR;
            PG8_LDA(At, 1, 1); PG8_STAGE(PG8_SA(1, 0), a3, voffA);
            PG8_BAR; PG8_WAIT_L(0); PG8_MMA(1, 0, At, B0); PG8_BAR; PG8_SCHED;
            PG8_STAGE(PG8_SB(1, 1), b3 + hstep, voffB);
            PG8_WAIT_V(6); PG8_BAR; PG8_MMA(1, 1, At, B1); PG8_BAR;
            }
        }
        if constexpr (ALIGN_EPI) { if (wr == 0) PG8_BAR; }
        if constexpr (!Epi::AFTER_DRAIN) { E(acc, cur, wr, wc, fr, fq); S.done(cur); }
        if (!has_next) break;
#pragma unroll
        for (int a = 0; a < 2; ++a)
#pragma unroll
            for (int b = 0; b < 2; ++b)
#pragma unroll
                for (int m = 0; m < 4; ++m)
#pragma unroll
                    for (int n = 0; n < 2; ++n) acc[a][b][m][n] = (f32x4){0.f, 0.f, 0.f, 0.f};
        cur = nxt; cA = nA; cB = nB; ++ui;
        if constexpr (ALIGN_EPI) { if (wr == 1) PG8_BAR; }
    }
    PG8_WAIT_V(0);
    if constexpr (!ALIGN_EPI) { if (wr == 0) PG8_BAR; }
    PG8_BAR;
    if constexpr (Epi::AFTER_DRAIN) { E.fused(acc, cur, wr, wc, fr, fq, lds, wid, lane); S.done(cur); }
#undef PG8_SA
#undef PG8_SB
#undef PG8_STAGE
#undef PG8_LDA
#undef PG8_LDB
#undef PG8_MMA
#undef PG8_WAIT_V
#undef PG8_WAIT_L
#undef PG8_BAR
#undef PG8_SCHED
}
typedef float f32x2 __attribute__((ext_vector_type(2)));
typedef unsigned u32x2v __attribute__((ext_vector_type(2)));
typedef __bf16 bf2_t __attribute__((ext_vector_type(2)));
__device__ __forceinline__ unsigned pk_bf16(float a, float b) { f32x2 v = {a, b}; bf2_t r = __builtin_convertvector(v, bf2_t); return __builtin_bit_cast(unsigned, r); }
__device__ __forceinline__ float bf_lo(unsigned w) { return __uint_as_float(w << 16); }
__device__ __forceinline__ float bf_hi(unsigned w) { return __uint_as_float(w & 0xffff0000u); }
__device__ __forceinline__ float sigmoidf_(float x) { return __builtin_amdgcn_rcpf(1.0f + __builtin_amdgcn_exp2f(-1.44269504f * x)); }

struct EpiF32 {
    static constexpr bool PERM = false, AFTER_DRAIN = false;
    float* C; int ldc;
    __device__ __forceinline__ void operator()(const f32x4 (&acc)[2][2][4][2], const Unit& u, int wr, int wc, int fr, int fq) const {
        const int row0 = u.pm * BM + wr * 64 + fr, col0 = u.pn * BM + wc * 32 + 4 * fq;
#pragma unroll
        for (int ai = 0; ai < 2; ++ai)
#pragma unroll
            for (int m = 0; m < 4; ++m) { float* rowp = C + (size_t)(row0 + ai * HALF + m * 16) * ldc + col0;
#pragma unroll
                for (int bj = 0; bj < 2; ++bj)
#pragma unroll
                    for (int n = 0; n < 2; ++n) *(f32x4*)(rowp + bj * HALF + n * 16) = acc[ai][bj][m][n]; }
    }
};
template <bool ACT> struct EpiGlu {
    static constexpr bool PERM = true, AFTER_DRAIN = false;
    bf16_t* O; int ldc;
    __device__ __forceinline__ void operator()(const f32x4 (&acc)[2][2][4][2], const Unit& u, int wr, int wc, int fr, int fq) const {
        const int row0 = u.pm * BM + wr * 64 + fr, col0 = u.pn * HALF + wc * 32 + 8 * fq;
#pragma unroll
        for (int ai = 0; ai < 2; ++ai)
#pragma unroll
            for (int m = 0; m < 4; ++m) { bf16_t* rowp = O + (size_t)(row0 + ai * HALF + m * 16) * ldc + col0;
                float v[8];
#pragma unroll
                for (int n = 0; n < 2; ++n)
#pragma unroll
                    for (int j = 0; j < 4; ++j) { const float g = acc[ai][0][m][n][j], up = acc[ai][1][m][n][j]; v[n * 4 + j] = ACT ? g * sigmoidf_(g) * up : g * up; }
                u32x4 w; w.x = pk_bf16(v[0], v[1]); w.y = pk_bf16(v[2], v[3]); w.z = pk_bf16(v[4], v[5]); w.w = pk_bf16(v[6], v[7]);
                *(u32x4*)rowp = w; }
    }
};
struct EpiBf16 {
    static constexpr bool PERM = true, AFTER_DRAIN = false;
    bf16_t* O; int ldc; int split_tiles; bf16_t* O2; int rope_tiles; const float* cs; const float* sn; int ldc2;
    __device__ __forceinline__ void operator()(const f32x4 (&acc)[2][2][4][2], const Unit& u, int wr, int wc, int fr, int fq) const {
        const int row0 = u.pm * BM + wr * 64 + fr; int pn = u.pn; bf16_t* base = O; int ld = ldc;
        if (split_tiles && pn >= split_tiles) { base = O2; pn -= split_tiles; ld = ldc2; }
        const int col0 = pn * BM + wc * 32 + 8 * fq;
        const bool rope = (u.pn < rope_tiles) && ((wc & 1) == 0);
#pragma unroll
        for (int ai = 0; ai < 2; ++ai)
#pragma unroll
            for (int m = 0; m < 4; ++m) { const int row = row0 + ai * HALF + m * 16; bf16_t* rowp = base + (size_t)row * ld + col0;
                f32x4 c0 = {1.f, 1.f, 1.f, 1.f}, c1 = c0, s0 = {0.f, 0.f, 0.f, 0.f}, s1 = s0;
                if (rope) { const int pos = row & 2047; c0 = *(const f32x4*)(cs + pos * 8); c1 = *(const f32x4*)(cs + pos * 8 + 4); s0 = *(const f32x4*)(sn + pos * 8); s1 = *(const f32x4*)(sn + pos * 8 + 4);
                    if (fq == 0) { s0 = -s0; s1 = -s1; } if (fq >= 2) { c0 = (f32x4){1.f, 1.f, 1.f, 1.f}; c1 = c0; s0 = (f32x4){0.f, 0.f, 0.f, 0.f}; s1 = s0; } }
#pragma unroll
                for (int bj = 0; bj < 2; ++bj) { f32x4 v0 = acc[ai][bj][m][0], v1 = acc[ai][bj][m][1];
                    if (rope) { f32x4 p0, p1;
#pragma unroll
                        for (int j = 0; j < 4; ++j) { p0[j] = __shfl_xor(v0[j], 16); p1[j] = __shfl_xor(v1[j], 16); }
                        v0 = v0 * c0 + p0 * s0; v1 = v1 * c1 + p1 * s1; }
                    u32x4 w; w.x = pk_bf16(v0[0], v0[1]); w.y = pk_bf16(v0[2], v0[3]); w.z = pk_bf16(v1[0], v1[1]); w.w = pk_bf16(v1[2], v1[3]);
                    *(u32x4*)(rowp + bj * HALF) = w; } }
    }
};
template <int PASS> struct EpiGate {
    static constexpr bool PERM = true, AFTER_DRAIN = false;
    const bf16_t* gl; int ldg; const float* bg; bf16_t* m1; bf16_t* mb; int ldc;
    __device__ __forceinline__ void operator()(const f32x4 (&acc)[2][2][4][2], const Unit& u, int wr, int wc, int fr, int fq) const {
        const int row0 = u.pm * BM + wr * 64 + fr, col0 = u.pn * BM + wc * 32 + 8 * fq;
#pragma unroll
        for (int bj = 0; bj < 2; ++bj) { const int col = col0 + bj * HALF;
            const f32x4 b0 = *(const f32x4*)(bg + col), b1 = *(const f32x4*)(bg + col + 4);
#pragma unroll
            for (int ai = 0; ai < 2; ++ai)
#pragma unroll
                for (int m = 0; m < 4; ++m) { const size_t row = (size_t)(row0 + ai * HALF + m * 16);
                    const u32x4 gw = *(const u32x4*)(gl + row * ldg + col);
                    f32x4 g0 = {bf_lo(gw.x), bf_hi(gw.x), bf_lo(gw.y), bf_hi(gw.y)}, g1 = {bf_lo(gw.z), bf_hi(gw.z), bf_lo(gw.w), bf_hi(gw.w)};
                    g0 += b0; g1 += b1; f32x4 v0 = acc[ai][bj][m][0], v1 = acc[ai][bj][m][1];
#pragma unroll
                    for (int j = 0; j < 4; ++j) { v0[j] *= sigmoidf_(g0[j]); v1[j] *= sigmoidf_(g1[j]); }
                    bf16_t* mp = m1 + row * ldc + col;
                    if (PASS == 2) { const u32x4 pw = *(const u32x4*)mp;
                        v0 += (f32x4){bf_lo(pw.x), bf_hi(pw.x), bf_lo(pw.y), bf_hi(pw.y)}; v1 += (f32x4){bf_lo(pw.z), bf_hi(pw.z), bf_lo(pw.w), bf_hi(pw.w)}; }
                    u32x4 w; w.x = pk_bf16(v0[0], v0[1]); w.y = pk_bf16(v0[2], v0[3]); w.z = pk_bf16(v1[0], v1[1]); w.w = pk_bf16(v1[2], v1[3]);
                    *(u32x4*)((PASS == 1 ? mp : mb + row * ldc + col)) = w; } }
    }
};
struct EpiNormRes {
    static constexpr bool PERM = false, AFTER_DRAIN = true;
    const float* xin; float* x; const float* wpost; float scale; const float* wpre; bf16_t* h; float* slots; unsigned* cnt; unsigned ex0;
    __device__ __forceinline__ void stats(const f32x4 (&v)[2][2][4][2], const Unit& u, int wr, int wc, int fr, int fq, PG8_LAS unsigned char* lds, int wid, int lane, unsigned ex) const {
        PG8_LAS float* P = (PG8_LAS float*)lds;
        PG8_LAS float* S = (PG8_LAS float*)(lds + 4096);
#pragma unroll
        for (int ai = 0; ai < 2; ++ai)
#pragma unroll
            for (int m = 0; m < 4; ++m) { float s = 0.f;
#pragma unroll
                for (int bj = 0; bj < 2; ++bj)
#pragma unroll
                    for (int n = 0; n < 2; ++n) { const f32x4 t = v[ai][bj][m][n]; s += (t[0] * t[0] + t[1] * t[1]) + (t[2] * t[2] + t[3] * t[3]); }
                s += __shfl_xor(s, 16); s += __shfl_xor(s, 32);
                if (fq == 0) P[(ai * HALF + wr * 64 + m * 16 + fr) * 4 + wc] = s; }
        asm volatile("s_waitcnt lgkmcnt(0)" ::: "memory"); __builtin_amdgcn_s_barrier(); asm volatile("" ::: "memory");
        const int row = wid * 32 + (lane & 31);
        float* slot = slots + ((size_t)(ex & 1u) * 16384 + (size_t)(u.pm * BM + row)) * 4;
        if (lane < 32) { const float tot = (P[row * 4 + 0] + P[row * 4 + 1]) + (P[row * 4 + 2] + P[row * 4 + 3]);
            __hip_atomic_store(slot + u.pn, tot, __ATOMIC_RELAXED, __HIP_MEMORY_SCOPE_AGENT); }
        asm volatile("s_waitcnt vmcnt(0)" ::: "memory");
        if (lane == 0) __hip_atomic_fetch_add(cnt + 64 * u.pm, 1u, __ATOMIC_RELAXED, __HIP_MEMORY_SCOPE_AGENT);
        if (wid == 0) { const unsigned want = 32u * (ex + 1u); unsigned spins = 0;
            while ((unsigned)__builtin_amdgcn_readfirstlane(__hip_atomic_load(cnt + 64 * u.pm, __ATOMIC_RELAXED, __HIP_MEMORY_SCOPE_AGENT)) < want) { __builtin_amdgcn_s_sleep(2); if (++spins > (1u << 22)) break; }
            __builtin_amdgcn_fence(__ATOMIC_ACQUIRE, "agent"); }
        asm volatile("s_waitcnt vmcnt(0) lgkmcnt(0)" ::: "memory"); __builtin_amdgcn_s_barrier(); asm volatile("" ::: "memory");
        if (lane < 32) { float q = 0.f;
#pragma unroll
            for (int t = 0; t < 4; ++t) q += __hip_atomic_load(slot + t, __ATOMIC_RELAXED, __HIP_MEMORY_SCOPE_AGENT);
            S[row] = __builtin_amdgcn_rsqf(q * (1.0f / 1024.0f) + 1e-6f); }
        asm volatile("s_waitcnt vmcnt(0) lgkmcnt(0)" ::: "memory"); __builtin_amdgcn_s_barrier(); asm volatile("" ::: "memory");
    }
    __device__ __forceinline__ void fused(f32x4 (&acc)[2][2][4][2], const Unit& u, int wr, int wc, int fr, int fq, PG8_LAS unsigned char* lds, int wid, int lane) const {
        const PG8_LAS float* S = (const PG8_LAS float*)(lds + 4096);
        const int col0 = u.pn * BM + wc * 32 + 4 * fq;
        stats(acc, u, wr, wc, fr, fq, lds, wid, lane, ex0);
#pragma unroll
        for (int ai = 0; ai < 2; ++ai)
#pragma unroll
            for (int m = 0; m < 4; ++m) { const int r = ai * HALF + wr * 64 + m * 16 + fr; const float rs = S[r] * scale; const size_t off = (size_t)(u.pm * BM + r) * 1024 + col0;
#pragma unroll
                for (int bj = 0; bj < 2; ++bj)
#pragma unroll
                    for (int n = 0; n < 2; ++n) { const f32x4 xv = *(const f32x4*)(xin + off + bj * HALF + n * 16); const f32x4 w = *(const f32x4*)(wpost + col0 + bj * HALF + n * 16);
                        const f32x4 o = xv + acc[ai][bj][m][n] * rs * w; acc[ai][bj][m][n] = o; *(f32x4*)(x + off + bj * HALF + n * 16) = o; }
                asm volatile("" : "+v"(acc[ai][0][m][0]), "+v"(acc[ai][0][m][1]), "+v"(acc[ai][1][m][0]), "+v"(acc[ai][1][m][1]));
                if (m & 1) asm volatile("" ::: "memory"); }
        if (h == nullptr) return;
        stats(acc, u, wr, wc, fr, fq, lds, wid, lane, ex0 + 1u);
#pragma unroll
        for (int ai = 0; ai < 2; ++ai)
#pragma unroll
            for (int m = 0; m < 4; ++m) { const int r = ai * HALF + wr * 64 + m * 16 + fr; const float rs = S[r]; const size_t off = (size_t)(u.pm * BM + r) * 1024 + col0;
#pragma unroll
                for (int bj = 0; bj < 2; ++bj)
#pragma unroll
                    for (int n = 0; n < 2; ++n) { const f32x4 w = *(const f32x4*)(wpre + col0 + bj * HALF + n * 16); const f32x4 o = acc[ai][bj][m][n] * rs * w;
                        u32x2v ov; ov.x = pk_bf16(o[0], o[1]); ov.y = pk_bf16(o[2], o[3]); *(u32x2v*)(h + off + bj * HALF + n * 16) = ov; } }
    }
};
}
#define LAS __attribute__((address_space(3)))
typedef unsigned short bf16_t;
typedef short bf16x8 __attribute__((ext_vector_type(8)));
typedef float f32x4 __attribute__((ext_vector_type(4)));
typedef float f32x16 __attribute__((ext_vector_type(16)));
typedef unsigned u32x4 __attribute__((ext_vector_type(4)));
typedef unsigned u32x2 __attribute__((ext_vector_type(2)));
using pg8::pk_bf16; using pg8::bf_lo; using pg8::bf_hi;

constexpr int MTOK = 16384, DM = 1024, SEQ = 2048, DFF = 2816, NTHR = 512;
constexpr int LDS_BYTES = 131072 + 16;
constexpr float EPS = 1e-6f;
constexpr size_t OFF_W13A = 0, OFF_W2A = 11534336, OFF_W13B = 17301504, OFF_W2B = 28835840, OFF_WIN = 34603008, OFF_WCO = 51380224, OFF_WAO = 53477376, OFF_WO = 55574528;
constexpr size_t OFF_HB = 57671680, OFF_TAB = OFF_HB + 33554432, OFF_RB = OFF_TAB + 131072;
constexpr size_t OFF_AB = OFF_RB, OFF_YF1 = OFF_RB + 92274688;
constexpr size_t OFF_TCH = OFF_RB, OFF_BB = OFF_RB + 33554432;
constexpr int QK_LD = 2048 + 128, VT_LD = 16384 + 128;
constexpr size_t OFF_QK = OFF_RB, OFF_VT = OFF_QK + (size_t)MTOK * QK_LD * 2, OFF_GL = OFF_VT + (size_t)1024 * VT_LD * 2, OFF_CB = OFF_GL + 67108864;
constexpr size_t OFF_M1 = OFF_QK, OFF_MB = OFF_VT, OFF_YF2 = OFF_GL, OFF_OB = OFF_HB;
constexpr size_t OFF_BAR = OFF_CB + 33554432;
constexpr size_t OFF_CNT = OFF_BAR + 16384;
constexpr size_t OFF_CEN = OFF_CNT + 16384;
constexpr size_t OFF_SLOT = OFF_CEN + 4096;
constexpr size_t WS_NEED = OFF_SLOT + 524288;

struct Params {
    const float* x; const float* w_in; const float* b_gate; const float* conv_w; const float* w_conv_out; const float* w_attn_out; const float* lam_vec; const float* subln_w;
    const float* w_o; const float* ffn1_w13; const float* ffn1_w2; const float* ffn2_w13; const float* ffn2_w2; const float* norm_w; float* out; unsigned char* ws;
};

typedef const __attribute__((address_space(4))) Params* KPtr_;
__device__ __forceinline__ void convert_weights(KPtr_ kp, int l, int t0, int t1, int bi, int nb) {
    Params p; p.ffn1_w13 = kp->ffn1_w13; p.ffn1_w2 = kp->ffn1_w2; p.ffn2_w13 = kp->ffn2_w13; p.ffn2_w2 = kp->ffn2_w2; p.w_in = kp->w_in; p.w_conv_out = kp->w_conv_out; p.w_attn_out = kp->w_attn_out; p.w_o = kp->w_o; unsigned char* ws = kp->ws;
    const int tid = opaque_tid(), n = tid & 63, kq = tid >> 6;
    for (int t = t0 + bi; t < t1; t += nb) {
        const float* src; bf16_t* dst; int K, ld, mode, tl;
        if (t < 352)       { tl = t;        src = p.ffn1_w13 + (size_t)l * 1024 * 5632; dst = (bf16_t*)(ws + OFF_W13A); K = 1024; ld = 5632; mode = 1; }
        else if (t < 528)  { tl = t - 352;  src = p.ffn1_w2 + (size_t)l * 2816 * 1024;  dst = (bf16_t*)(ws + OFF_W2A);  K = 2816; ld = 1024; mode = 0; }
        else if (t < 880)  { tl = t - 528;  src = p.ffn2_w13 + (size_t)l * 1024 * 5632; dst = (bf16_t*)(ws + OFF_W13B); K = 1024; ld = 5632; mode = 1; }
        else if (t < 1056) { tl = t - 880;  src = p.ffn2_w2 + (size_t)l * 2816 * 1024;  dst = (bf16_t*)(ws + OFF_W2B);  K = 2816; ld = 1024; mode = 0; }
        else if (t < 1568) { tl = t - 1056; src = p.w_in + (size_t)l * 1024 * 8192;     dst = (bf16_t*)(ws + OFF_WIN);  K = 1024; ld = 8192; mode = 2; }
        else if (t < 1632) { tl = t - 1568; src = p.w_conv_out + (size_t)l * 1048576;   dst = (bf16_t*)(ws + OFF_WCO);  K = 1024; ld = 1024; mode = 0; }
        else if (t < 1696) { tl = t - 1632; src = p.w_attn_out + (size_t)l * 1048576;   dst = (bf16_t*)(ws + OFF_WAO);  K = 1024; ld = 1024; mode = 0; }
        else               { tl = t - 1696; src = p.w_o + (size_t)l * 1048576;          dst = (bf16_t*)(ws + OFF_WO);   K = 1024; ld = 1024; mode = 0; }
        const int KT = K / 256, nb = tl / KT, kb = tl % KT, n0 = nb * 64; int src0 = n0;
        if (mode == 1) { const int pn = n0 >> 8, bj = (n0 >> 7) & 1, jj = n0 & 127; src0 = bj * DFF + pn * 128 + jj; }
        if (mode == 2) {
            if (n0 < 2048) { const int pn = n0 >> 8, bj = (n0 >> 7) & 1, jj = n0 & 127; src0 = 1024 + bj * 1024 + pn * 128 + jj; }
            else if (n0 < 3072) src0 = n0 - 2048;
            else src0 = (n0 < 5120) ? n0 : (n0 < 7168 ? n0 + 1024 : n0 - 2048); }
        const int k0 = kb * 256 + kq * 32;
        const float* sp = src + (size_t)k0 * ld + src0 + n;
        float v[32];
#pragma unroll
        for (int j = 0; j < 32; ++j) v[j] = sp[(size_t)j * ld];
        bf16_t* dp = dst + (size_t)(n0 + n) * K + k0;
#pragma unroll
        for (int q = 0; q < 4; ++q) { u32x4 w; w.x = pk_bf16(v[8 * q], v[8 * q + 1]); w.y = pk_bf16(v[8 * q + 2], v[8 * q + 3]); w.z = pk_bf16(v[8 * q + 4], v[8 * q + 5]); w.w = pk_bf16(v[8 * q + 6], v[8 * q + 7]);
            *(u32x4*)(dp + 8 * q) = w; }
    }
}
__device__ __forceinline__ void rope_tables(float* cs, float* sn) {
    for (int i = blockIdx.x * NTHR + opaque_tid(); i < SEQ * 8; i += gridDim.x * NTHR) {
        const int pos = i >> 3, j = i & 7;
        const float inv = (float)pow(500000.0, -(double)j / 8.0);
        const float ang = (float)pos * inv;
        cs[i] = (float)cos((double)ang); sn[i] = (float)sin((double)ang);
    }
}

__device__ __forceinline__ float sum16(float v) { v += __shfl_xor(v, 8); v += __shfl_xor(v, 4); v += __shfl_xor(v, 2); v += __shfl_xor(v, 1); return v; }
template <int MODE> __device__ __forceinline__ void row_phase(const float* xin, float* x, const bf16_t* y, const float* wpost, float scale, const float* wpre, bf16_t* h) {
    const int tid = opaque_tid(), lane = tid & 63, wid = tid >> 6, sub = lane >> 4, l16 = lane & 15;
    for (int row = (blockIdx.x * 8 + wid) * 4 + sub; row < MTOK; row += gridDim.x * 32) {
        const size_t ro = (size_t)row * DM + l16 * 4;
        f32x4 xv[16];
        if (MODE == 0 || MODE == 3) {
#pragma unroll
            for (int i = 0; i < 16; ++i) xv[i] = *(const f32x4*)(xin + ro + i * 64);
        } else {
            f32x4 yv[16]; float ss = 0.f;
#pragma unroll
            for (int i = 0; i < 16; ++i) { const u32x2 yw = *(const u32x2*)(y + ro + i * 64); yv[i] = (f32x4){bf_lo(yw.x), bf_hi(yw.x), bf_lo(yw.y), bf_hi(yw.y)}; xv[i] = *(const f32x4*)(x + ro + i * 64); }
#pragma unroll
            for (int i = 0; i < 16; ++i) ss += yv[i][0] * yv[i][0] + yv[i][1] * yv[i][1] + yv[i][2] * yv[i][2] + yv[i][3] * yv[i][3];
            ss = sum16(ss); const float rs = scale * __builtin_amdgcn_rsqf(ss * (1.0f / DM) + EPS);
#pragma unroll
            for (int i = 0; i < 16; ++i) { const f32x4 w = *(const f32x4*)(wpost + l16 * 4 + i * 64); xv[i] += yv[i] * rs * w; }
        }
        if (MODE != 3) {
#pragma unroll
            for (int i = 0; i < 16; ++i) *(f32x4*)(x + ro + i * 64) = xv[i]; }
        if (MODE != 2) {
            float ss = 0.f;
#pragma unroll
            for (int i = 0; i < 16; ++i) ss += xv[i][0] * xv[i][0] + xv[i][1] * xv[i][1] + xv[i][2] * xv[i][2] + xv[i][3] * xv[i][3];
            ss = sum16(ss); const float rs = __builtin_amdgcn_rsqf(ss * (1.0f / DM) + EPS);
#pragma unroll
            for (int i = 0; i < 16; ++i) { const f32x4 w = *(const f32x4*)(wpre + l16 * 4 + i * 64); const f32x4 v = xv[i] * rs * w;
                u32x2 o; o.x = pk_bf16(v[0], v[1]); o.y = pk_bf16(v[2], v[3]); *(u32x2*)(h + ro + i * 64) = o; }
        }
    }
}

__device__ __forceinline__ void ld8(const bf16_t* p, float (&v)[8]) { const u32x4 w = *(const u32x4*)p; v[0] = bf_lo(w.x); v[1] = bf_hi(w.x); v[2] = bf_lo(w.y); v[3] = bf_hi(w.y); v[4] = bf_lo(w.z); v[5] = bf_hi(w.z); v[6] = bf_lo(w.w); v[7] = bf_hi(w.w); }
__device__ __forceinline__ void conv_phase(const bf16_t* tb, const bf16_t* bb, const float* cw, bf16_t* cb) {
    for (int item = blockIdx.x * NTHR + opaque_tid(); item < 262144; item += gridDim.x * NTHR) {
        const int cgp = item & 127, chunk = item >> 7, c0 = cgp * 8, tok0 = chunk * 8, s0 = tok0 & (SEQ - 1);
        u32x4 tr[10], br[8];
        const u32x4 z4 = {0u, 0u, 0u, 0u};
#pragma unroll
        for (int i = 0; i < 10; ++i) { const int s = s0 - 1 + i; const bool ok = (s >= 0) && (s < SEQ); tr[i] = ok ? *(const u32x4*)(tb + (size_t)(tok0 - 1 + i) * DM + c0) : z4; }
#pragma unroll
        for (int i = 0; i < 8; ++i) br[i] = *(const u32x4*)(bb + (size_t)(tok0 + i) * DM + c0);
        float w0[8], w1[8], w2[8];
#pragma unroll
        for (int j = 0; j < 8; ++j) { w0[j] = cw[c0 + j]; w1[j] = cw[1024 + c0 + j]; w2[j] = cw[2048 + c0 + j]; }
        float tp[8], tc[8], tn[8];
#define CONV_T(dst, i) do { const u32x4 a_ = tr[i]; dst[0] = bf_lo(a_.x); dst[1] = bf_hi(a_.x); dst[2] = bf_lo(a_.y); dst[3] = bf_hi(a_.y); dst[4] = bf_lo(a_.z); dst[5] = bf_hi(a_.z); dst[6] = bf_lo(a_.w); dst[7] = bf_hi(a_.w); } while (0)
        CONV_T(tp, 0); CONV_T(tc, 1);
#pragma unroll
        for (int i = 0; i < 8; ++i) {
            CONV_T(tn, i + 2);
            const u32x4 bw = br[i]; const float bv[8] = {bf_lo(bw.x), bf_hi(bw.x), bf_lo(bw.y), bf_hi(bw.y), bf_lo(bw.z), bf_hi(bw.z), bf_lo(bw.w), bf_hi(bw.w)};
            float o[8];
#pragma unroll
            for (int j = 0; j < 8; ++j) { o[j] = bv[j] * (w0[j] * tp[j] + w1[j] * tc[j] + w2[j] * tn[j]); tp[j] = tc[j]; tc[j] = tn[j]; }
            u32x4 w; w.x = pk_bf16(o[0], o[1]); w.y = pk_bf16(o[2], o[3]); w.z = pk_bf16(o[4], o[5]); w.w = pk_bf16(o[6], o[7]);
            *(u32x4*)(cb + (size_t)(tok0 + i) * DM + c0) = w;
        }
#undef CONV_T
    }
}

#ifndef ATT_SCHED
#define ATT_SCHED 0
#endif
__device__ __forceinline__ float fmax3(float a, float b, float c) { return fmaxf(fmaxf(a, b), c); }
__device__ __forceinline__ void attn_phase(LAS unsigned char* lds, const bf16_t* qk, const bf16_t* vt, bf16_t* ob, const float* lv, const float* subln, float lam_init, int vcb) {
    const int tid = opaque_tid(), wid = __builtin_amdgcn_readfirstlane(tid >> 6), lane = tid & 63, r = lane & 31, hf = lane >> 5;
    const int c = wid >> 2, qw = wid & 3;
    float d1 = 0.f, d2 = 0.f;
    for (int i = 0; i < 64; ++i) { d1 += lv[i] * lv[64 + i]; d2 += lv[128 + i] * lv[192 + i]; }
    const float lam = expf(d1) - expf(d2) + lam_init;
    const float C2 = 0.125f * 1.44269504f;
    const int G = gridDim.x, cb = vcb;
    const int pr = (r & ~12) | ((r & 4) << 1) | ((r & 8) >> 1);
    const int ksw = (pr >> 1) & 7, vsw = (r >> 1) & 7;
    const int srow = tid >> 3, sch = tid & 7;
    for (int it = 0;; ++it) {
        const int u = it * G + cb; if (u >= 1024) break;
        int bh, qb;
        if (G == 256) { bh = it * 16 + (cb & 7) * 2 + (cb >> 7); qb = (cb >> 3) & 15; } else { bh = u >> 4; qb = u & 15; }
        const int b = bh >> 3, h = bh & 7;
        const size_t tok0 = (size_t)b * SEQ;
        const size_t qtok = tok0 + qb * 128 + qw * 32 + r;
        const bf16_t* qrow = qk + qtok * QK_LD + h * 128 + c * 64 + 8 * hf;
        bf16x8 Qf[4];
#pragma unroll
        for (int kk = 0; kk < 4; ++kk) Qf[kk] = *(const bf16x8*)(qrow + 16 * kk);
        f32x16 O[4];
#pragma unroll
        for (int d = 0; d < 4; ++d)
#pragma unroll
            for (int i = 0; i < 16; ++i) O[d][i] = 0.f;
        float mrun = -1e30f, lrun = 0.f;
        const int gch = sch ^ ((srow >> 1) & 7);
        const bf16_t* kg = qk + (tok0 + srow) * QK_LD + 1024 + h * 128 + gch * 8;
        const bf16_t* vg = vt + (size_t)(h * 128 + srow) * VT_LD + tok0 + gch * 8;
#define ATT_ISSUE(t) do { const int tt_ = ((t) + 2 * qb) & 31; LAS unsigned char* bs = lds + ((t) & 3) * 32768 + wid * 1024; \
            __builtin_amdgcn_global_load_lds((const unsigned*)(kg + (size_t)tt_ * 64 * QK_LD), (LAS unsigned*)(bs), 16, 0, 0); \
            __builtin_amdgcn_global_load_lds((const unsigned*)(kg + (size_t)tt_ * 64 * QK_LD + 64), (LAS unsigned*)(bs + 8192), 16, 0, 0); \
            __builtin_amdgcn_global_load_lds((const unsigned*)(vg + tt_ * 64), (LAS unsigned*)(bs + 16384), 16, 0, 0); \
            __builtin_amdgcn_global_load_lds((const unsigned*)(vg + tt_ * 64 + (size_t)64 * VT_LD), (LAS unsigned*)(bs + 24576), 16, 0, 0); } while (0)
#define ATT_KLD(buf) do { const LAS unsigned char* kb_ = lds + (buf) * 32768 + c * 8192 + pr * 128; \
            _Pragma("unroll") for (int kk = 0; kk < 4; ++kk) { const int off = ((2 * kk + hf) ^ ksw) << 4; Kf[kk] = *(const LAS bf16x8*)(kb_ + off); Kf[4 + kk] = *(const LAS bf16x8*)(kb_ + 32 * 128 + off); } } while (0)
#define ATT_QKM(D0, D1) do { _Pragma("unroll") for (int i = 0; i < 16; ++i) { D0[i] = 0.f; D1[i] = 0.f; } \
            _Pragma("unroll") for (int kk = 0; kk < 4; ++kk) { D0 = __builtin_amdgcn_mfma_f32_32x32x16_bf16(Kf[kk], Qf[kk], D0, 0, 0, 0); D1 = __builtin_amdgcn_mfma_f32_32x32x16_bf16(Kf[4 + kk], Qf[kk], D1, 0, 0, 0); } } while (0)
#define ATT_VLD(DST, buf, d0) do { const LAS unsigned char* vb_ = lds + (buf) * 32768 + 16384 + r * 128; \
            _Pragma("unroll") for (int dd = 0; dd < 2; ++dd) _Pragma("unroll") for (int kb = 0; kb < 2; ++kb) _Pragma("unroll") for (int s = 0; s < 2; ++s) \
                DST[dd * 4 + kb * 2 + s] = *(const LAS bf16x8*)(vb_ + ((d0) + dd) * 32 * 128 + (((4 * kb + 2 * s + hf) ^ vsw) << 4)); } while (0)
#define ATT_PVM(SRC, d0) do { _Pragma("unroll") for (int kb = 0; kb < 2; ++kb) _Pragma("unroll") for (int s = 0; s < 2; ++s) _Pragma("unroll") for (int dd = 0; dd < 2; ++dd) \
                O[(d0) + dd] = __builtin_amdgcn_mfma_f32_32x32x16_bf16(SRC[dd * 4 + kb * 2 + s], P[kb][s], O[(d0) + dd], 0, 0, 0); } while (0)
#define ATT_BAR() do { asm volatile("" ::: "memory"); __builtin_amdgcn_s_barrier(); asm volatile("" ::: "memory"); } while (0)
#define ATT_SB() __builtin_amdgcn_sched_barrier(0)
        ATT_ISSUE(0); ATT_ISSUE(1); if (c == 0) ATT_ISSUE(2);
        asm volatile("s_waitcnt vmcnt(0)" ::: "memory"); ATT_BAR();
        f32x16 S0, S1;
        bf16x8 Kf[8], VA[8];
        bf16x8 P[2][2];
        ATT_KLD(0); ATT_QKM(S0, S1);
#define ATT_PV(buf) do { ATT_VLD(VA, (buf), 0); ATT_SB(); ATT_PVM(VA, 0); ATT_SB(); ATT_VLD(VA, (buf), 2); ATT_SB(); ATT_PVM(VA, 2); ATT_SB(); } while (0)
        for (int t = 0; t < 32; ++t) {
            if (c == 1 && t < 30) ATT_ISSUE(t + 2);
            if (t > 0) ATT_PV((t - 1) & 3);
            if (c == 0) { asm volatile("s_waitcnt vmcnt(0)" ::: "memory"); ATT_BAR(); if (t < 29) ATT_ISSUE(t + 3); }
            ATT_KLD((t + 1) & 3);
            ATT_SB();
            float tm = fmaxf(S0[0], S1[0]);
#pragma unroll
            for (int i = 1; i < 16; ++i) tm = fmax3(tm, S0[i], S1[i]);
            tm = fmaxf(tm, __shfl_xor(tm, 32));
            const bool upd = tm > mrun + 64.0f;
            const float mn = upd ? tm : mrun, alpha = __builtin_amdgcn_exp2f((mrun - mn) * C2), mc = mn * C2;
            mrun = mn;
            if (__builtin_amdgcn_ballot_w64(upd) != 0ull) {
#pragma unroll
                for (int d = 0; d < 4; ++d)
#pragma unroll
                    for (int i = 0; i < 16; ++i) O[d][i] *= alpha;
            }
            ATT_SB();
            f32x16 N0, N1;
            ATT_QKM(N0, N1);
            float rs = 0.f;
#pragma unroll
            for (int i = 0; i < 16; ++i) { S0[i] = __builtin_amdgcn_exp2f(S0[i] * C2 - mc); S1[i] = __builtin_amdgcn_exp2f(S1[i] * C2 - mc); rs += S0[i] + S1[i]; }
            lrun = lrun * alpha + rs;
#pragma unroll
            for (int s = 0; s < 2; ++s) {
                u32x4 w0, w1;
                w0.x = pk_bf16(S0[8 * s + 0], S0[8 * s + 1]); w0.y = pk_bf16(S0[8 * s + 2], S0[8 * s + 3]); w0.z = pk_bf16(S0[8 * s + 4], S0[8 * s + 5]); w0.w = pk_bf16(S0[8 * s + 6], S0[8 * s + 7]);
                w1.x = pk_bf16(S1[8 * s + 0], S1[8 * s + 1]); w1.y = pk_bf16(S1[8 * s + 2], S1[8 * s + 3]); w1.z = pk_bf16(S1[8 * s + 4], S1[8 * s + 5]); w1.w = pk_bf16(S1[8 * s + 6], S1[8 * s + 7]);
                P[0][s] = __builtin_bit_cast(bf16x8, w0); P[1][s] = __builtin_bit_cast(bf16x8, w1);
            }
            ATT_SB();
            if (c == 1) { asm volatile("s_waitcnt vmcnt(0)" ::: "memory"); ATT_BAR(); }
            S0 = N0; S1 = N1;
        }
        ATT_PV(31 & 3);
#undef ATT_PV
#undef ATT_KLD
#undef ATT_QKM
#undef ATT_VLD
#undef ATT_PVM
#undef ATT_ISSUE
        const float lt = lrun + __shfl_xor(lrun, 32);
        LAS float* X = (LAS float*)lds + qw * 4096 + lane;
        if (c == 1) { const float sc = lam / lt;
#pragma unroll
            for (int d = 0; d < 4; ++d)
#pragma unroll
                for (int i = 0; i < 16; ++i) X[(d * 16 + i) * 64] = O[d][i] * sc; }
        __syncthreads();
        if (c == 0) { const float sc = 1.0f / lt; float ss = 0.f;
#pragma unroll
            for (int d = 0; d < 4; ++d)
#pragma unroll
                for (int i = 0; i < 16; ++i) { const float o = O[d][i] * sc - X[(d * 16 + i) * 64]; O[d][i] = o; ss += o * o; }
            ss += __shfl_xor(ss, 32);
            const float rms = __builtin_amdgcn_rsqf(ss * (1.0f / 128.0f) + EPS) * (1.0f - lam_init);
            bf16_t* orow = ob + qtok * DM + h * 128 + 4 * hf;
#pragma unroll
            for (int d = 0; d < 4; ++d)
#pragma unroll
                for (int g = 0; g < 4; ++g) { const int dv = 32 * d + 8 * g;
                    const f32x4 w = *(const f32x4*)(subln + dv + 4 * hf);
                    u32x2 o; o.x = pk_bf16(O[d][4 * g] * rms * w[0], O[d][4 * g + 1] * rms * w[1]); o.y = pk_bf16(O[d][4 * g + 2] * rms * w[2], O[d][4 * g + 3] * rms * w[3]);
                    *(u32x2*)(orow + dv) = o; } }
        __syncthreads();
    }
}
#define XB_TMO      128
#define XB_XCNT(j)  (256  + 64 * (j))
#define XB_XSUB(j)  (1280 + 64 * (j))
#define XB_XGEN(j)  (2304 + 64 * (j))
#define XB_TOP      3328
#define XB_TOPGEN   3392
#define XCD_BAR_WORDS 3456
#define XB_SPIN_CAP (1u << 18)

__device__ __forceinline__ unsigned xb_ld(unsigned* p)              { return __hip_atomic_load(p, __ATOMIC_RELAXED, __HIP_MEMORY_SCOPE_AGENT); }
__device__ __forceinline__ unsigned xb_add(unsigned* p, unsigned v) { return __hip_atomic_fetch_add(p, v, __ATOMIC_RELAXED, __HIP_MEMORY_SCOPE_AGENT); }
__device__ __forceinline__ unsigned xb_xcc_id() { return (unsigned)__builtin_amdgcn_s_getreg((3 << 11) | 20) & 0xFu; }
#define XB_SPIN(cond, bar) do { unsigned _sp = 0; while (cond) { __builtin_amdgcn_s_sleep(1); \
    if ((++_sp & 255u) == 0u) { if (xb_ld(&(bar)[XB_TMO])) break; if (_sp > XB_SPIN_CAP) { atomicAdd(&(bar)[XB_TMO], 1u); break; } } } } while (0)

struct XcdBarrier {
    unsigned* bar; unsigned x;
    volatile LAS unsigned* st;
};

__device__ __forceinline__ XcdBarrier xcd_barrier_post(unsigned* bar, volatile LAS unsigned* st) {
    XcdBarrier b; b.bar = bar; b.x = xb_xcc_id(); b.st = st;
    if (threadIdx.x == 0) (void)xb_add(&bar[XB_XCNT(b.x)], 1u);
    return b;
}
__device__ __forceinline__ void xcd_barrier_complete(unsigned* bar, unsigned x, unsigned& nloc, unsigned& nx) {
    const unsigned G = gridDim.x * gridDim.y * gridDim.z;
    unsigned sum, cnt, mine, sp = 0u;
    for (;;) {
        sum = 0u; cnt = 0u; mine = 0u;
#pragma unroll
        for (unsigned j = 0; j < 16; ++j) { const unsigned c = xb_ld(&bar[XB_XCNT(j)]); sum += c; cnt += (c > 0u) ? 1u : 0u; mine = (j == x) ? c : mine; }
        if (sum == G) break;
        __builtin_amdgcn_s_sleep(1);
        if ((++sp & 255u) == 0u) { if (xb_ld(&bar[XB_TMO])) break; if (sp > XB_SPIN_CAP) { atomicAdd(&bar[XB_TMO], 1u); break; } }
    }
    nloc = mine > 0u ? mine : 1u; nx = cnt > 0u ? cnt : 1u;
}

__device__ __forceinline__ void xcd_barrier(const XcdBarrier& b) {
    asm volatile("s_waitcnt vmcnt(0)" ::: "memory");
    __syncthreads();
    if (threadIdx.x == 0) {
        unsigned* bar = b.bar;
        __builtin_amdgcn_s_waitcnt(0);
        unsigned nloc = b.st[0], nx = b.st[1];
        if (nloc == 0u) { xcd_barrier_complete(bar, b.x, nloc, nx); b.st[0] = nloc; b.st[1] = nx; }
        const unsigned old = xb_add(&bar[XB_XSUB(b.x)], 1u);
        const unsigned gen = old / nloc;
        if (old + 1u == (gen + 1u) * nloc) {
            __builtin_amdgcn_fence(__ATOMIC_RELEASE, "agent");
            asm volatile("s_waitcnt vmcnt(0)" ::: "memory");
            const unsigned og = xb_add(&bar[XB_TOP], 1u);
            const unsigned tg = og / nx;
            if (og + 1u == (tg + 1u) * nx) xb_add(&bar[XB_TOPGEN], 1u);
            else XB_SPIN(xb_ld(&bar[XB_TOPGEN]) == tg, bar);
            __builtin_amdgcn_fence(__ATOMIC_ACQUIRE, "agent");
            xb_add(&bar[XB_XGEN(b.x)], 1u);
            asm volatile("s_waitcnt vmcnt(0)" ::: "memory");
        } else {
            XB_SPIN(xb_ld(&bar[XB_XGEN(b.x)]) == gen, bar);
            __builtin_amdgcn_fence(__ATOMIC_ACQUIRE, "agent");
            asm volatile("s_waitcnt vmcnt(0)" ::: "memory");
        }
    }
    __syncthreads();
}
#ifndef REP_GEMM
#define REP_GEMM 1
#endif
#ifndef REP_ATTN
#define REP_ATTN 1
#endif
#ifndef REP_CONV
#define REP_CONV 1
#endif
#ifndef REP_CVT
#define REP_CVT 1
#endif
#ifndef REP_SYNC
#define REP_SYNC 1
#endif
#define GSYNC() do { for (int rep_ = 0; rep_ < REP_SYNC; ++rep_) xcd_barrier(bar); } while (0)
template <class Epi> __device__ __forceinline__ void run_gemm_(LAS unsigned char* lds, const bf16_t* A, const bf16_t* Bt, int M, int N, int K, const Epi& E, int vcb) {
    pg8::Gemm g{A, Bt, M, N, K}; pg8::StaticOrder S; S.init(M, N, (int)gridDim.x, vcb);
    for (int rep = 0; rep < REP_GEMM; ++rep) pg8::gemm_phase<Epi, pg8::StaticOrder, !Epi::AFTER_DRAIN, true>(lds, g, S, E);
}

typedef const __attribute__((address_space(4))) Params* KPtr;
__device__ __forceinline__ KPtr kparams() { KPtr kp = (KPtr)__builtin_amdgcn_kernarg_segment_ptr(); asm volatile("" : "+s"(kp)); return kp; }
#define WSP(T, off) ((T*)(kparams()->ws + (off)))
__device__ __forceinline__ int vcb_read(LAS unsigned char* lds) { unsigned off = 131072u + 8u; asm volatile("" : "+v"(off)); return (int)__builtin_amdgcn_readfirstlane(*(volatile LAS unsigned*)(lds + off)); }
#define VCB() vcb_read(lds)
#define run_gemm(...) run_gemm_(__VA_ARGS__, VCB())
template <bool fusedn> __global__ void __launch_bounds__(NTHR) fwd_megakernel(Params p_unused) {
    extern __shared__ __attribute__((aligned(16))) unsigned char smem[];
    cg::grid_group grid = cg::this_grid();
    LAS unsigned char* lds = (LAS unsigned char*)smem;
    if (threadIdx.x < 4) ((LAS unsigned*)(lds + 131072))[threadIdx.x] = 0u;
    __syncthreads();
    const XcdBarrier bar = xcd_barrier_post(WSP(unsigned, OFF_BAR), (volatile LAS unsigned*)(lds + 131072));
    if (threadIdx.x == 0) { unsigned* cen = WSP(unsigned, OFF_CEN); ((volatile LAS unsigned*)(lds + 131072))[3] = __hip_atomic_fetch_add(cen + 64 * bar.x, 1u, __ATOMIC_RELAXED, __HIP_MEMORY_SCOPE_AGENT); }

    { const KPtr kp = kparams(); for (int rep = 0; rep < REP_CVT; ++rep) convert_weights(kp, 0, 0, 528, (int)blockIdx.x, (int)gridDim.x); }
    rope_tables(WSP(float, OFF_TAB), WSP(float, OFF_TAB) + SEQ * 8);
    { const KPtr kp = kparams(); if constexpr (fusedn) row_phase<3>(kp->x, nullptr, nullptr, nullptr, 0.f, kp->norm_w, WSP(bf16_t, OFF_HB)); else row_phase<0>(kp->x, kp->out, nullptr, nullptr, 0.f, kp->norm_w, WSP(bf16_t, OFF_HB)); }
    grid.sync();
    if (threadIdx.x == 0) { unsigned* cen = WSP(unsigned, OFF_CEN); const unsigned per = gridDim.x >> 3; bool ok = (gridDim.x & 7u) == 0u && bar.x < 8u;
        for (int j = 0; j < 8; ++j) ok = ok && (__hip_atomic_load(cen + 64 * j, __ATOMIC_RELAXED, __HIP_MEMORY_SCOPE_AGENT) == per);
        volatile LAS unsigned* w = (volatile LAS unsigned*)(lds + 131072); w[2] = ok ? (w[3] * 8u + bar.x) : blockIdx.x; }
    __syncthreads();
    for (int l = 0; l < 2; ++l) {
        run_gemm(lds, WSP(bf16_t, OFF_HB), WSP(bf16_t, OFF_W13A), MTOK, 2 * DFF, DM, pg8::EpiGlu<true>{WSP(bf16_t, OFF_AB), DFF});
        { const int rem = 1408 % (int)gridDim.x, vc = VCB(); const KPtr kp = kparams();
          if (rem == 0) convert_weights(kp, l, 528, 1760, vc, (int)gridDim.x); else if (vc >= rem) convert_weights(kp, l, 528, 1760, vc - rem, (int)gridDim.x - rem); }
        GSYNC();
        if constexpr (fusedn) { const KPtr kp = kparams(); const float* nw = kp->norm_w + (size_t)l * 6 * DM;
            run_gemm(lds, WSP(bf16_t, OFF_AB), WSP(bf16_t, OFF_W2A), MTOK, DM, DFF, pg8::EpiNormRes{l == 0 ? kp->x : kp->out, kp->out, nw + DM, 0.5f, nw + 2 * DM, WSP(bf16_t, OFF_HB), WSP(float, OFF_SLOT), WSP(unsigned, OFF_CNT), (unsigned)(l * 6)}); }
        else { run_gemm(lds, WSP(bf16_t, OFF_AB), WSP(bf16_t, OFF_W2A), MTOK, DM, DFF, pg8::EpiBf16{WSP(bf16_t, OFF_YF1), DM, 0, nullptr, 0, nullptr, nullptr, 0}); GSYNC();
            const KPtr kp = kparams(); const float* nw = kp->norm_w + (size_t)l * 6 * DM; row_phase<1>(nullptr, kp->out, WSP(bf16_t, OFF_YF1), nw + DM, 0.5f, nw + 2 * DM, WSP(bf16_t, OFF_HB)); }
        GSYNC();
        run_gemm(lds, WSP(bf16_t, OFF_HB), WSP(bf16_t, OFF_WIN), MTOK, 2048, DM, pg8::EpiGlu<false>{WSP(bf16_t, OFF_TCH), DM});
        run_gemm(lds, WSP(bf16_t, OFF_HB), WSP(bf16_t, OFF_WIN) + (size_t)2048 * DM, MTOK, 1024, DM, pg8::EpiBf16{WSP(bf16_t, OFF_BB), DM, 0, nullptr, 0, nullptr, nullptr, 0});
        GSYNC();
        for (int rep = 0; rep < REP_CONV; ++rep) conv_phase(WSP(bf16_t, OFF_TCH), WSP(bf16_t, OFF_BB), kparams()->conv_w + (size_t)l * 3 * DM, WSP(bf16_t, OFF_CB));
        GSYNC();
        run_gemm(lds, WSP(bf16_t, OFF_HB), WSP(bf16_t, OFF_WIN) + (size_t)3072 * DM, MTOK, 4096, DM, pg8::EpiBf16{WSP(bf16_t, OFF_QK), QK_LD, 8, WSP(bf16_t, OFF_GL), 8, WSP(float, OFF_TAB), WSP(float, OFF_TAB) + SEQ * 8, 2048});
        run_gemm(lds, WSP(bf16_t, OFF_WIN) + (size_t)7168 * DM, WSP(bf16_t, OFF_HB), DM, MTOK, DM, pg8::EpiBf16{WSP(bf16_t, OFF_VT), VT_LD, 0, nullptr, 0, nullptr, nullptr, 0});
        GSYNC();
        { const KPtr kp = kparams(); const float lam_init = 0.8f - 0.6f * expf(-0.3f * (float)l);
          for (int rep = 0; rep < REP_ATTN; ++rep) attn_phase(lds, WSP(bf16_t, OFF_QK), WSP(bf16_t, OFF_VT), WSP(bf16_t, OFF_OB), kp->lam_vec + (size_t)l * 256, kp->subln_w + (size_t)l * 128, lam_init, VCB()); }
        GSYNC();
        run_gemm(lds, WSP(bf16_t, OFF_CB), WSP(bf16_t, OFF_WCO), MTOK, DM, DM, pg8::EpiGate<1>{WSP(bf16_t, OFF_GL), 2048, kparams()->b_gate + (size_t)l * 2048, WSP(bf16_t, OFF_M1), WSP(bf16_t, OFF_MB), DM});
        run_gemm(lds, WSP(bf16_t, OFF_OB), WSP(bf16_t, OFF_WAO), MTOK, DM, DM, pg8::EpiGate<2>{WSP(bf16_t, OFF_GL) + 1024, 2048, kparams()->b_gate + (size_t)l * 2048 + 1024, WSP(bf16_t, OFF_M1), WSP(bf16_t, OFF_MB), DM});
        GSYNC();
        if constexpr (fusedn) { const KPtr kp = kparams(); const float* nw = kp->norm_w + (size_t)l * 6 * DM;
            run_gemm(lds, WSP(bf16_t, OFF_MB), WSP(bf16_t, OFF_WO), MTOK, DM, DM, pg8::EpiNormRes{kp->out, kp->out, nw + 3 * DM, 1.0f, nw + 4 * DM, WSP(bf16_t, OFF_HB), WSP(float, OFF_SLOT), WSP(unsigned, OFF_CNT), (unsigned)(l * 6 + 2)}); }
        else { run_gemm(lds, WSP(bf16_t, OFF_MB), WSP(bf16_t, OFF_WO), MTOK, DM, DM, pg8::EpiBf16{WSP(bf16_t, OFF_YF2), DM, 0, nullptr, 0, nullptr, nullptr, 0}); GSYNC();
            const KPtr kp = kparams(); const float* nw = kp->norm_w + (size_t)l * 6 * DM; row_phase<1>(nullptr, kp->out, WSP(bf16_t, OFF_YF2), nw + 3 * DM, 1.0f, nw + 4 * DM, WSP(bf16_t, OFF_HB)); }
        GSYNC();
        run_gemm(lds, WSP(bf16_t, OFF_HB), WSP(bf16_t, OFF_W13B), MTOK, 2 * DFF, DM, pg8::EpiGlu<true>{WSP(bf16_t, OFF_AB), DFF});
        if (l == 0) { const int rem = 1408 % (int)gridDim.x, vc = VCB(); const KPtr kp = kparams();
          if (rem == 0) convert_weights(kp, 1, 0, 528, vc, (int)gridDim.x); else if (vc >= rem) convert_weights(kp, 1, 0, 528, vc - rem, (int)gridDim.x - rem); }
        GSYNC();
        if constexpr (fusedn) { const KPtr kp = kparams(); const float* nw = kp->norm_w + (size_t)l * 6 * DM;
            run_gemm(lds, WSP(bf16_t, OFF_AB), WSP(bf16_t, OFF_W2B), MTOK, DM, DFF, pg8::EpiNormRes{kp->out, kp->out, nw + 5 * DM, 0.5f, nw + 6 * DM, l == 0 ? WSP(bf16_t, OFF_HB) : nullptr, WSP(float, OFF_SLOT), WSP(unsigned, OFF_CNT), (unsigned)(l * 6 + 4)}); }
        else { run_gemm(lds, WSP(bf16_t, OFF_AB), WSP(bf16_t, OFF_W2B), MTOK, DM, DFF, pg8::EpiBf16{WSP(bf16_t, OFF_YF1), DM, 0, nullptr, 0, nullptr, nullptr, 0}); GSYNC();
            const KPtr kp = kparams(); const float* nw = kp->norm_w + (size_t)l * 6 * DM;
            if (l == 0) row_phase<1>(nullptr, kp->out, WSP(bf16_t, OFF_YF1), nw + 5 * DM, 0.5f, nw + 6 * DM, WSP(bf16_t, OFF_HB));
            else row_phase<2>(nullptr, kp->out, WSP(bf16_t, OFF_YF1), nw + 5 * DM, 0.5f, nullptr, nullptr); }
        if (l == 0) GSYNC();
    }
}

extern "C" void kernel_launch(void* const* d_in, const int* in_sizes, int n_in, void* d_out, int out_size, void* d_ws, size_t ws_size, hipStream_t stream) {
    static int grid_blocks = 0; static const void* kfn = nullptr;
    if (grid_blocks == 0) {
        if (ws_size < WS_NEED) { fprintf(stderr, "kernel_launch: workspace too small: %zu < %zu\n", ws_size, (size_t)WS_NEED); grid_blocks = -1; return; }
        int dev = 0, cus = 0, per_cu = 0;
        (void)hipGetDevice(&dev);
        (void)hipDeviceGetAttribute(&cus, hipDeviceAttributeMultiprocessorCount, dev);
        kfn = (cus == 256) ? (const void*)fwd_megakernel<true> : (const void*)fwd_megakernel<false>;
        if (hipFuncSetAttribute((const void*)kfn, hipFuncAttributeMaxDynamicSharedMemorySize, LDS_BYTES) != hipSuccess) { fprintf(stderr, "kernel_launch: hipFuncSetAttribute failed\n"); grid_blocks = -1; return; }
        if (hipOccupancyMaxActiveBlocksPerMultiprocessor(&per_cu, (const void*)kfn, NTHR, LDS_BYTES) != hipSuccess || per_cu < 1) { fprintf(stderr, "kernel_launch: occupancy query failed (%d)\n", per_cu); grid_blocks = -1; return; }
        grid_blocks = cus * 1;
        fprintf(stderr, "kernel_launch: cus %d per_cu %d grid %d ws %zu\n", cus, per_cu, grid_blocks, ws_size);
    }
    if (grid_blocks < 0) return;
    if (hipMemsetAsync((char*)d_ws + OFF_BAR, 0, 32768 + 4096, stream) != hipSuccess) { fprintf(stderr, "kernel_launch: memset failed\n"); return; }
    Params p{};
    p.x = (const float*)d_in[0]; p.w_in = (const float*)d_in[1]; p.b_gate = (const float*)d_in[2]; p.conv_w = (const float*)d_in[3]; p.w_conv_out = (const float*)d_in[4];
    p.w_attn_out = (const float*)d_in[5]; p.lam_vec = (const float*)d_in[6]; p.subln_w = (const float*)d_in[7]; p.w_o = (const float*)d_in[8];
    p.ffn1_w13 = (const float*)d_in[9]; p.ffn1_w2 = (const float*)d_in[10]; p.ffn2_w13 = (const float*)d_in[11]; p.ffn2_w2 = (const float*)d_in[12]; p.norm_w = (const float*)d_in[13];
    p.out = (float*)d_out; p.ws = (unsigned char*)d_ws;
    void* args[] = {&p};
    hipError_t e = hipLaunchCooperativeKernel((const void*)kfn, dim3(grid_blocks), dim3(NTHR), args, LDS_BYTES, stream);
    if (e != hipSuccess) fprintf(stderr, "cooperative launch failed: %s (grid %d)\n", hipGetErrorString(e), grid_blocks);
}
```

```cpp
#include <hip/hip_runtime.h>
#include <hip/hip_cooperative_groups.h>
#include <cstdio>
namespace cg = cooperative_groups;
__device__ __forceinline__ int opaque_tid() { int t = threadIdx.x; asm volatile("" : "+v"(t)); return t; }
namespace pg8 {
#define PG8_LAS __attribute__((address_space(3)))
typedef unsigned short bf16_t;
typedef short bf16x8 __attribute__((ext_vector_type(8)));
typedef float f32x4 __attribute__((ext_vector_type(4)));
typedef unsigned u32x4 __attribute__((ext_vector_type(4)));
constexpr int BM = 256, BK = 64, HALF = 128, HTB = HALF * BK * 2  , STAGE_BYTES = 8 * HTB, NXCD = 8, WGM = 8;

__host__ __device__ __forceinline__ int lds_byte(int r, int c) { const int st = (r >> 4) * 2 + (c >> 5), rr = r & 15, cc = c & 31, ob = rr * 64 + cc * 2; return st * 1024 + (ob ^ (((ob >> 9) & 1) << 5)); }
__host__ __device__ __forceinline__ void stage_rc(int b, int& R, int& C) { const int st = b / 1024, sb = b % 1024, swz = sb ^ (((sb >> 9) & 1) << 5); R = (st >> 1) * 16 + swz / 64; C = (st & 1) * 32 + (swz % 64) / 2; }
__host__ __device__ __forceinline__ int perm32(int rho) { const int n = rho >> 4, i = rho & 15; return 8 * (i >> 2) + 4 * n + (i & 3); }

struct Unit { int pm, pn, sel; };
struct Gemm { const bf16_t* A; const bf16_t* Bt; int M, N, K; const bf16_t* A2; const bf16_t* Bt2; };

struct StaticOrder {
    int nM, nN, nwg, G, c;
    __host__ __device__ void init(int M, int N, int G_, int c_) { nM = M / BM; nN = N / BM; nwg = nM * nN; G = G_; c = c_; }
    __host__ __device__ bool next(int i, Unit& u) const { return map((long)i * G + c, u); }
    __host__ __device__ bool map(long L, Unit& u) const {
        if (L >= nwg) return false;
        u.sel = 0;
        int wgid = (int)L; { const int q = nwg / NXCD, r = nwg % NXCD, xcd = wgid % NXCD, off = wgid / NXCD; wgid = (xcd < r ? xcd * (q + 1) : r * (q + 1) + (xcd - r) * q) + off; }
        const int nig = WGM * nN, gid = wgid / nig, fm = gid * WGM, gsz = (nM - fm) < WGM ? (nM - fm) : WGM;
        u.pm = fm + ((wgid % nig) % gsz); u.pn = (wgid % nig) / gsz; return true;
    }
    __device__ __forceinline__ void a_ready(const Unit&) const {}
    __device__ __forceinline__ void done(const Unit&) const {}
};
struct DualOrder {
    StaticOrder s0, s1; int G, c;
    __host__ __device__ void init(int M0, int N0, int M1, int N1, int G_, int c_) { s0.init(M0, N0, G_, c_); s1.init(M1, N1, G_, c_); G = G_; c = c_; }
    __host__ __device__ bool next(int i, Unit& u) const {
        long L = (long)i * G + c; if (L < s0.nwg) return s0.map(L, u);
        L -= s0.nwg; if (!s1.map(L, u)) return false; u.sel = 1; return true; }
    __device__ __forceinline__ void a_ready(const Unit&) const {}
    __device__ __forceinline__ void done(const Unit&) const {}
};

template <class Epi, class Sched, bool ALIGN_EPI = false, bool SP2 = false>
__device__ __forceinline__ void gemm_phase(PG8_LAS unsigned char* lds, const Gemm g, const Sched& S, const Epi& E) {
    const int tid = opaque_tid(), wid = __builtin_amdgcn_readfirstlane(tid >> 6), lane = tid & 63, wr = wid >> 2, wc = wid & 3, fr = lane & 15, fq = lane >> 4;
    const int K = g.K, nt = K / BK;
    unsigned voffA[2], voffB[2];
#pragma unroll
    for (int i = 0; i < 2; ++i) { int R, C; stage_rc(tid * 16 + i * 8192, R, C); const int Rb = Epi::PERM ? ((R & ~31) + perm32(R & 31)) : R;
        voffA[i] = (unsigned)(R * K + C) * 2u; voffB[i] = (unsigned)(Rb * K + C) * 2u; }
    const size_t kstep = (size_t)(BK * 2);
    const size_t hstep = (size_t)HALF * K * 2;
    const size_t tstep = 2 * hstep;
    const unsigned ldsw = (unsigned)wid * 1024u;
    const int aoff = lds_byte(wr * 64 + fr, fq * 8), boff = lds_byte(wc * 32 + fr, fq * 8);
#define PG8_SA(b, h) (((b) * 2 + (h)) * HTB)
#define PG8_SB(b, h) ((4 + (b) * 2 + (h)) * HTB)
#define PG8_STAGE(bufoff, gbase, voff) do { _Pragma("unroll") for (int _i = 0; _i < 2; ++_i) \
        __builtin_amdgcn_global_load_lds((const unsigned*)((const char*)(gbase) + (voff)[_i]), (PG8_LAS unsigned*)(lds + (bufoff) + ldsw + _i * 8192), 16, 0, 0); } while (0)
#define PG8_LDA(dst, b, h) do { _Pragma("unroll") for (int m = 0; m < 4; ++m) _Pragma("unroll") for (int k = 0; k < 2; ++k) dst[m][k] = *(const PG8_LAS bf16x8*)(lds + PG8_SA(b, h) + aoff + m * 2048 + k * 1024); } while (0)
#define PG8_LDB(dst, b, h) do { _Pragma("unroll") for (int n = 0; n < 2; ++n) _Pragma("unroll") for (int k = 0; k < 2; ++k) dst[n][k] = *(const PG8_LAS bf16x8*)(lds + PG8_SB(b, h) + boff + n * 2048 + k * 1024); } while (0)
#define PG8_MMA(ai, bj, At, Bt) do { __builtin_amdgcn_s_setprio(1); _Pragma("unroll") for (int m = 0; m < 4; ++m) _Pragma("unroll") for (int n = 0; n < 2; ++n) _Pragma("unroll") for (int k = 0; k < 2; ++k) \
        acc[ai][bj][m][n] = __builtin_amdgcn_mfma_f32_16x16x32_bf16(Bt[n][k], At[m][k], acc[ai][bj][m][n], 0, 0, 0); __builtin_amdgcn_s_setprio(0); } while (0)
#define PG8_WAIT_V(n) asm volatile("s_waitcnt vmcnt(" #n ")" ::: "memory")
#define PG8_WAIT_L(n) asm volatile("s_waitcnt lgkmcnt(" #n ")" ::: "memory")
#define PG8_BAR __builtin_amdgcn_s_barrier()
#define PG8_SCHED __builtin_amdgcn_sched_barrier(0)
    Unit cur, nxt; int ui = 0;
    if (!S.next(0, cur)) return;
    f32x4 acc[2][2][4][2];
#pragma unroll
    for (int a = 0; a < 2; ++a)
#pragma unroll
        for (int b = 0; b < 2; ++b)
#pragma unroll
            for (int m = 0; m < 4; ++m)
#pragma unroll
                for (int n = 0; n < 2; ++n) acc[a][b][m][n] = (f32x4){0.f, 0.f, 0.f, 0.f};
    bf16x8 At[4][2], B0[2][2], B1[2][2];
    const char* cA = (const char*)(cur.sel ? g.A2 : g.A) + (size_t)cur.pm * tstep; const char* cB = (const char*)(cur.sel ? g.Bt2 : g.Bt) + (size_t)cur.pn * tstep;
    S.a_ready(cur);
    if constexpr (SP2) {
        PG8_STAGE(PG8_SB(0, 0), cB, voffB); PG8_STAGE(PG8_SB(0, 1), cB + hstep, voffB); PG8_STAGE(PG8_SA(0, 0), cA, voffA); PG8_STAGE(PG8_SA(0, 1), cA + hstep, voffA);
        if (wr == 1) PG8_BAR;
        PG8_WAIT_V(2); PG8_BAR;
        PG8_STAGE(PG8_SB(1, 0), cB + kstep, voffB); PG8_STAGE(PG8_SA(1, 0), cA + kstep, voffA); PG8_STAGE(PG8_SB(1, 1), cB + hstep + kstep, voffB);
        PG8_WAIT_V(6); PG8_BAR;
    } else {
        PG8_STAGE(PG8_SB(0, 0), cB, voffB); PG8_STAGE(PG8_SA(0, 0), cA, voffA); PG8_STAGE(PG8_SB(0, 1), cB + hstep, voffB); PG8_STAGE(PG8_SA(0, 1), cA + hstep, voffA);
        if (wr == 1) PG8_BAR;
        PG8_WAIT_V(4); PG8_BAR;
        PG8_STAGE(PG8_SB(1, 0), cB + kstep, voffB); PG8_STAGE(PG8_SA(1, 0), cA + kstep, voffA); PG8_STAGE(PG8_SB(1, 1), cB + hstep + kstep, voffB);
        PG8_WAIT_V(6); PG8_BAR;
    }
    for (;;) {
        const bool has_next = S.next(ui + 1, nxt);
        const char* nA = has_next ? (const char*)(nxt.sel ? g.A2 : g.A) + (size_t)nxt.pm * tstep : cA; const char* nB = has_next ? (const char*)(nxt.sel ? g.Bt2 : g.Bt) + (size_t)nxt.pn * tstep : cB;
        for (int t = 0; t < nt; t += 2) {
            const bool last = (t == nt - 2);
            const char* a1 = cA + (size_t)(t + 1) * kstep;
            const char* a2 = last ? nA : cA + (size_t)(t + 2) * kstep; const char* b2 = last ? nB : cB + (size_t)(t + 2) * kstep;
            const char* a3 = a2 + kstep; const char* b3 = b2 + kstep;
            if (last && has_next) S.a_ready(nxt);
            if constexpr (SP2) {
            PG8_LDB(B0, 0, 0); PG8_LDB(B1, 0, 1); PG8_SCHED; PG8_LDA(At, 0, 0); PG8_STAGE(PG8_SA(1, 1), a1 + hstep, voffA);
            PG8_WAIT_V(8); PG8_WAIT_L(0); PG8_BAR; PG8_MMA(0, 0, At, B0); PG8_MMA(0, 1, At, B1); PG8_BAR; PG8_SCHED;
            PG8_LDA(At, 0, 1); PG8_STAGE(PG8_SB(0, 0), b2, voffB); PG8_STAGE(PG8_SB(0, 1), b2 + hstep, voffB); PG8_STAGE(PG8_SA(0, 0), a2, voffA);
            PG8_WAIT_V(8); PG8_WAIT_L(0); PG8_BAR; PG8_MMA(1, 0, At, B0); PG8_MMA(1, 1, At, B1); PG8_BAR; PG8_SCHED;
            PG8_LDB(B0, 1, 0); PG8_LDB(B1, 1, 1); PG8_SCHED; PG8_LDA(At, 1, 0); PG8_STAGE(PG8_SA(0, 1), a2 + hstep, voffA);
            PG8_WAIT_V(8); PG8_WAIT_L(0); PG8_BAR; PG8_MMA(0, 0, At, B0); PG8_MMA(0, 1, At, B1); PG8_BAR; PG8_SCHED;
            PG8_LDA(At, 1, 1); PG8_STAGE(PG8_SB(1, 0), b3, voffB); PG8_STAGE(PG8_SB(1, 1), b3 + hstep, voffB); PG8_STAGE(PG8_SA(1, 0), a3, voffA);
            PG8_WAIT_V(8); PG8_WAIT_L(0); PG8_BAR; PG8_MMA(1, 0, At, B0); PG8_MMA(1, 1, At, B1); PG8_BAR; PG8_SCHED;
            } else {
            PG8_LDB(B0, 0, 0); PG8_SCHED; PG8_LDA(At, 0, 0); PG8_STAGE(PG8_SA(1, 1), a1 + hstep, voffA);
            PG8_WAIT_L(8); PG8_BAR; PG8_WAIT_L(0); PG8_MMA(0, 0, At, B0); PG8_BAR; PG8_SCHED;
            PG8_LDB(B1, 0, 1); PG8_STAGE(PG8_SB(0, 0), b2, voffB);
            PG8_BAR; PG8_WAIT_L(0); PG8_MMA(0, 1, At, B1); PG8_BAR;
            PG8_LDA(At, 0, 1); PG8_STAGE(PG8_SA(0, 0), a2, voffA);
            PG8_BAR; PG8_WAIT_L(0); PG8_MMA(1, 0, At, B0); PG8_BAR; PG8_SCHED;
            PG8_STAGE(PG8_SB(0, 1), b2 + hstep, voffB);
            PG8_WAIT_V(6); PG8_BAR; PG8_MMA(1, 1, At, B1); PG8_BAR;
            PG8_LDB(B0, 1, 0); PG8_SCHED; PG8_LDA(At, 1, 0); PG8_STAGE(PG8_SA(0, 1), a2 + hstep, voffA);
            PG8_WAIT_L(8); PG8_BAR; PG8_WAIT_L(0); PG8_MMA(0, 0, At, B0); PG8_BAR; PG8_SCHED;
            PG8_LDB(B1, 1, 1); PG8_STAGE(PG8_SB(1, 0), b3, voffB);
            PG8_BAR; PG8_WAIT_L(0); PG8_MMA(0, 1, At, B1); PG8_BAR;
            PG8_LDA(At, 1, 1); PG8_STAGE(PG8_SA(1, 0), a3, voffA);
            PG8_BAR; PG8_WAIT_L(0); PG8_MMA(1, 0, At, B0); PG8_BAR; PG8_SCHED;
            PG8_STAGE(PG8_SB(1, 1), b3 + hstep, voffB);
            PG8_WAIT_V(6); PG8_BAR; PG8_MMA(1, 1, At, B1); PG8_BAR;
            }
        }
        if constexpr (ALIGN_EPI) { if (wr == 0) PG8_BAR; }
        if constexpr (!Epi::AFTER_DRAIN) { E(acc, cur, wr, wc, fr, fq); S.done(cur); }
        if (!has_next) break;
#pragma unroll
        for (int a = 0; a < 2; ++a)
#pragma unroll
            for (int b = 0; b < 2; ++b)
#pragma unroll
                for (int m = 0; m < 4; ++m)
#pragma unroll
                    for (int n = 0; n < 2; ++n) acc[a][b][m][n] = (f32x4){0.f, 0.f, 0.f, 0.f};
        cur = nxt; cA = nA; cB = nB; ++ui;
        if constexpr (ALIGN_EPI) { if (wr == 1) PG8_BAR; }
    }
    PG8_WAIT_V(0);
    if constexpr (!ALIGN_EPI) { if (wr == 0) PG8_BAR; }
    PG8_BAR;
    if constexpr (Epi::AFTER_DRAIN) { E.fused(acc, cur, wr, wc, fr, fq, lds, wid, lane); S.done(cur); }
#undef PG8_SA
#undef PG8_SB
#undef PG8_STAGE
#undef PG8_LDA
#undef PG8_LDB
#undef PG8_MMA
#undef PG8_WAIT_V
#undef PG8_WAIT_L
#undef PG8_BAR
#undef PG8_SCHED
}
typedef float f32x2 __attribute__((ext_vector_type(2)));
typedef unsigned u32x2v __attribute__((ext_vector_type(2)));
typedef __bf16 bf2_t __attribute__((ext_vector_type(2)));
__device__ __forceinline__ unsigned pk_bf16(float a, float b) { f32x2 v = {a, b}; bf2_t r = __builtin_convertvector(v, bf2_t); return __builtin_bit_cast(unsigned, r); }
__device__ __forceinline__ float bf_lo(unsigned w) { return __uint_as_float(w << 16); }
__device__ __forceinline__ float bf_hi(unsigned w) { return __uint_as_float(w & 0xffff0000u); }
__device__ __forceinline__ float sigmoidf_(float x) { return __builtin_amdgcn_rcpf(1.0f + __builtin_amdgcn_exp2f(-1.44269504f * x)); }

struct EpiF32 {
    static constexpr bool PERM = false, AFTER_DRAIN = false;
    float* C; int ldc;
    __device__ __forceinline__ void operator()(const f32x4 (&acc)[2][2][4][2], const Unit& u, int wr, int wc, int fr, int fq) const {
        const int row0 = u.pm * BM + wr * 64 + fr, col0 = u.pn * BM + wc * 32 + 4 * fq;
#pragma unroll
        for (int ai = 0; ai < 2; ++ai)
#pragma unroll
            for (int m = 0; m < 4; ++m) { float* rowp = C + (size_t)(row0 + ai * HALF + m * 16) * ldc + col0;
#pragma unroll
                for (int bj = 0; bj < 2; ++bj)
#pragma unroll
                    for (int n = 0; n < 2; ++n) *(f32x4*)(rowp + bj * HALF + n * 16) = acc[ai][bj][m][n]; }
    }
};
template <bool ACT> struct EpiGlu {
    static constexpr bool PERM = true, AFTER_DRAIN = false;
    bf16_t* O; int ldc;
    __device__ __forceinline__ void operator()(const f32x4 (&acc)[2][2][4][2], const Unit& u, int wr, int wc, int fr, int fq) const {
        const int row0 = u.pm * BM + wr * 64 + fr, col0 = u.pn * HALF + wc * 32 + 8 * fq;
#pragma unroll
        for (int ai = 0; ai < 2; ++ai)
#pragma unroll
            for (int m = 0; m < 4; ++m) { bf16_t* rowp = O + (size_t)(row0 + ai * HALF + m * 16) * ldc + col0;
                float v[8];
#pragma unroll
                for (int n = 0; n < 2; ++n)
#pragma unroll
                    for (int j = 0; j < 4; ++j) { const float g = acc[ai][0][m][n][j], up = acc[ai][1][m][n][j]; v[n * 4 + j] = ACT ? g * sigmoidf_(g) * up : g * up; }
                u32x4 w; w.x = pk_bf16(v[0], v[1]); w.y = pk_bf16(v[2], v[3]); w.z = pk_bf16(v[4], v[5]); w.w = pk_bf16(v[6], v[7]);
                *(u32x4*)rowp = w; }
    }
};
struct EpiBf16 {
    static constexpr bool PERM = true, AFTER_DRAIN = false;
    bf16_t* O; int ldc; int split_tiles; bf16_t* O2; int rope_tiles; const float* cs; const float* sn; int ldc2;
    __device__ __forceinline__ void operator()(const f32x4 (&acc)[2][2][4][2], const Unit& u, int wr, int wc, int fr, int fq) const {
        const int row0 = u.pm * BM + wr * 64 + fr; int pn = u.pn; bf16_t* base = O; int ld = ldc;
        if (split_tiles && pn >= split_tiles) { base = O2; pn -= split_tiles; ld = ldc2; }
        const int col0 = pn * BM + wc * 32 + 8 * fq;
        const bool rope = (u.pn < rope_tiles) && ((wc & 1) == 0);
#pragma unroll
        for (int ai = 0; ai < 2; ++ai)
#pragma unroll
            for (int m = 0; m < 4; ++m) { const int row = row0 + ai * HALF + m * 16; bf16_t* rowp = base + (size_t)row * ld + col0;
                f32x4 c0 = {1.f, 1.f, 1.f, 1.f}, c1 = c0, s0 = {0.f, 0.f, 0.f, 0.f}, s1 = s0;
                if (rope) { const int pos = row & 2047; c0 = *(const f32x4*)(cs + pos * 8); c1 = *(const f32x4*)(cs + pos * 8 + 4); s0 = *(const f32x4*)(sn + pos * 8); s1 = *(const f32x4*)(sn + pos * 8 + 4);
                    if (fq == 0) { s0 = -s0; s1 = -s1; } if (fq >= 2) { c0 = (f32x4){1.f, 1.f, 1.f, 1.f}; c1 = c0; s0 = (f32x4){0.f, 0.f, 0.f, 0.f}; s1 = s0; } }
#pragma unroll
                for (int bj = 0; bj < 2; ++bj) { f32x4 v0 = acc[ai][bj][m][0], v1 = acc[ai][bj][m][1];
                    if (rope) { f32x4 p0, p1;
#pragma unroll
                        for (int j = 0; j < 4; ++j) { p0[j] = __shfl_xor(v0[j], 16); p1[j] = __shfl_xor(v1[j], 16); }
                        v0 = v0 * c0 + p0 * s0; v1 = v1 * c1 + p1 * s1; }
                    u32x4 w; w.x = pk_bf16(v0[0], v0[1]); w.y = pk_bf16(v0[2], v0[3]); w.z = pk_bf16(v1[0], v1[1]); w.w = pk_bf16(v1[2], v1[3]);
                    *(u32x4*)(rowp + bj * HALF) = w; } }
    }
};
template <int PASS> struct EpiGate {
    static constexpr bool PERM = true, AFTER_DRAIN = false;
    const bf16_t* gl; int ldg; const float* bg; bf16_t* m1; bf16_t* mb; int ldc;
    __device__ __forceinline__ void operator()(const f32x4 (&acc)[2][2][4][2], const Unit& u, int wr, int wc, int fr, int fq) const {
        const int row0 = u.pm * BM + wr * 64 + fr, col0 = u.pn * BM + wc * 32 + 8 * fq;
#pragma unroll
        for (int bj = 0; bj < 2; ++bj) { const int col = col0 + bj * HALF;
            const f32x4 b0 = *(const f32x4*)(bg + col), b1 = *(const f32x4*)(bg + col + 4);
#pragma unroll
            for (int ai = 0; ai < 2; ++ai)
#pragma unroll
                for (int m = 0; m < 4; ++m) { const size_t row = (size_t)(row0 + ai * HALF + m * 16);
                    const u32x4 gw = *(const u32x4*)(gl + row * ldg + col);
                    f32x4 g0 = {bf_lo(gw.x), bf_hi(gw.x), bf_lo(gw.y), bf_hi(gw.y)}, g1 = {bf_lo(gw.z), bf_hi(gw.z), bf_lo(gw.w), bf_hi(gw.w)};
                    g0 += b0; g1 += b1; f32x4 v0 = acc[ai][bj][m][0], v1 = acc[ai][bj][m][1];
#pragma unroll
                    for (int j = 0; j < 4; ++j) { v0[j] *= sigmoidf_(g0[j]); v1[j] *= sigmoidf_(g1[j]); }
                    bf16_t* mp = m1 + row * ldc + col;
                    if (PASS == 2) { const u32x4 pw = *(const u32x4*)mp;
                        v0 += (f32x4){bf_lo(pw.x), bf_hi(pw.x), bf_lo(pw.y), bf_hi(pw.y)}; v1 += (f32x4){bf_lo(pw.z), bf_hi(pw.z), bf_lo(pw.w), bf_hi(pw.w)}; }
                    u32x4 w; w.x = pk_bf16(v0[0], v0[1]); w.y = pk_bf16(v0[2], v0[3]); w.z = pk_bf16(v1[0], v1[1]); w.w = pk_bf16(v1[2], v1[3]);
                    *(u32x4*)((PASS == 1 ? mp : mb + row * ldc + col)) = w; } }
    }
};
struct EpiNormRes {
    static constexpr bool PERM = false, AFTER_DRAIN = true;
    const float* xin; float* x; const float* wpost; float scale; const float* wpre; bf16_t* h; float* slots; unsigned* cnt; unsigned ex0;
    __device__ __forceinline__ void stats(const f32x4 (&v)[2][2][4][2], const Unit& u, int wr, int wc, int fr, int fq, PG8_LAS unsigned char* lds, int wid, int lane, unsigned ex) const {
        PG8_LAS float* P = (PG8_LAS float*)lds;
        PG8_LAS float* S = (PG8_LAS float*)(lds + 4096);
#pragma unroll
        for (int ai = 0; ai < 2; ++ai)
#pragma unroll
            for (int m = 0; m < 4; ++m) { float s = 0.f;
#pragma unroll
                for (int bj = 0; bj < 2; ++bj)
#pragma unroll
                    for (int n = 0; n < 2; ++n) { const f32x4 t = v[ai][bj][m][n]; s += (t[0] * t[0] + t[1] * t[1]) + (t[2] * t[2] + t[3] * t[3]); }
                s += __shfl_xor(s, 16); s += __shfl_xor(s, 32);
                if (fq == 0) P[(ai * HALF + wr * 64 + m * 16 + fr) * 4 + wc] = s; }
        asm volatile("s_waitcnt lgkmcnt(0)" ::: "memory"); __builtin_amdgcn_s_barrier(); asm volatile("" ::: "memory");
        const int row = wid * 32 + (lane & 31);
        float* slot = slots + ((size_t)(ex & 1u) * 16384 + (size_t)(u.pm * BM + row)) * 4;
        if (lane < 32) { const float tot = (P[row * 4 + 0] + P[row * 4 + 1]) + (P[row * 4 + 2] + P[row * 4 + 3]);
            __hip_atomic_store(slot + u.pn, tot, __ATOMIC_RELAXED, __HIP_MEMORY_SCOPE_AGENT); }
        asm volatile("s_waitcnt vmcnt(0)" ::: "memory");
        if (lane == 0) __hip_atomic_fetch_add(cnt + 64 * u.pm, 1u, __ATOMIC_RELAXED, __HIP_MEMORY_SCOPE_AGENT);
        if (wid == 0) { const unsigned want = 32u * (ex + 1u); unsigned spins = 0;
            while ((unsigned)__builtin_amdgcn_readfirstlane(__hip_atomic_load(cnt + 64 * u.pm, __ATOMIC_RELAXED, __HIP_MEMORY_SCOPE_AGENT)) < want) { __builtin_amdgcn_s_sleep(2); if (++spins > (1u << 22)) break; }
            __builtin_amdgcn_fence(__ATOMIC_ACQUIRE, "agent"); }
        asm volatile("s_waitcnt vmcnt(0) lgkmcnt(0)" ::: "memory"); __builtin_amdgcn_s_barrier(); asm volatile("" ::: "memory");
        if (lane < 32) { float q = 0.f;
#pragma unroll
            for (int t = 0; t < 4; ++t) q += __hip_atomic_load(slot + t, __ATOMIC_RELAXED, __HIP_MEMORY_SCOPE_AGENT);
            S[row] = __builtin_amdgcn_rsqf(q * (1.0f / 1024.0f) + 1e-6f); }
        asm volatile("s_waitcnt vmcnt(0) lgkmcnt(0)" ::: "memory"); __builtin_amdgcn_s_barrier(); asm volatile("" ::: "memory");
    }
    __device__ __forceinline__ void fused(f32x4 (&acc)[2][2][4][2], const Unit& u, int wr, int wc, int fr, int fq, PG8_LAS unsigned char* lds, int wid, int lane) const {
        const PG8_LAS float* S = (const PG8_LAS float*)(lds + 4096);
        const int col0 = u.pn * BM + wc * 32 + 4 * fq;
        stats(acc, u, wr, wc, fr, fq, lds, wid, lane, ex0);
#pragma unroll
        for (int ai = 0; ai < 2; ++ai)
#pragma unroll
            for (int m = 0; m < 4; ++m) { const int r = ai * HALF + wr * 64 + m * 16 + fr; const float rs = S[r] * scale; const size_t off = (size_t)(u.pm * BM + r) * 1024 + col0;
#pragma unroll
                for (int bj = 0; bj < 2; ++bj)
#pragma unroll
                    for (int n = 0; n < 2; ++n) { const f32x4 xv = *(const f32x4*)(xin + off + bj * HALF + n * 16); const f32x4 w = *(const f32x4*)(wpost + col0 + bj * HALF + n * 16);
                        const f32x4 o = xv + acc[ai][bj][m][n] * rs * w; acc[ai][bj][m][n] = o; *(f32x4*)(x + off + bj * HALF + n * 16) = o; }
                asm volatile("" : "+v"(acc[ai][0][m][0]), "+v"(acc[ai][0][m][1]), "+v"(acc[ai][1][m][0]), "+v"(acc[ai][1][m][1]));
                if (m & 1) asm volatile("" ::: "memory"); }
        if (h == nullptr) return;
        stats(acc, u, wr, wc, fr, fq, lds, wid, lane, ex0 + 1u);
#pragma unroll
        for (int ai = 0; ai < 2; ++ai)
#pragma unroll
            for (int m = 0; m < 4; ++m) { const int r = ai * HALF + wr * 64 + m * 16 + fr; const float rs = S[r]; const size_t off = (size_t)(u.pm * BM + r) * 1024 + col0;
#pragma unroll
                for (int bj = 0; bj < 2; ++bj)
#pragma unroll
                    for (int n = 0; n < 2; ++n) { const f32x4 w = *(const f32x4*)(wpre + col0 + bj * HALF + n * 16); const f32x4 o = acc[ai][bj][m][n] * rs * w;
                        u32x2v ov; ov.x = pk_bf16(o[0], o[1]); ov.y = pk_bf16(o[2], o[3]); *(u32x2v*)(h + off + bj * HALF + n * 16) = ov; } }
    }
};
template <class E0, class E1> struct EpiSplitN {
    static constexpr bool PERM = E0::PERM, AFTER_DRAIN = false;
    static_assert(E0::PERM == E1::PERM && !E0::AFTER_DRAIN && !E1::AFTER_DRAIN, "composite epilogue parts must agree");
    E0 e0; E1 e1; int split;
    __device__ __forceinline__ void operator()(const f32x4 (&acc)[2][2][4][2], const Unit& u, int wr, int wc, int fr, int fq) const {
        if (u.pn < split) e0(acc, u, wr, wc, fr, fq); else { Unit v = u; v.pn -= split; e1(acc, v, wr, wc, fr, fq); } }
};
template <class E0, class E1> struct EpiSel {
    static constexpr bool PERM = E0::PERM, AFTER_DRAIN = false;
    static_assert(E0::PERM == E1::PERM && !E0::AFTER_DRAIN && !E1::AFTER_DRAIN, "composite epilogue parts must agree");
    E0 e0; E1 e1;
    __device__ __forceinline__ void operator()(const f32x4 (&acc)[2][2][4][2], const Unit& u, int wr, int wc, int fr, int fq) const {
        if (u.sel) e1(acc, u, wr, wc, fr, fq); else e0(acc, u, wr, wc, fr, fq); }
};
}
#define LAS __attribute__((address_space(3)))
typedef unsigned short bf16_t;
typedef short bf16x8 __attribute__((ext_vector_type(8)));
typedef float f32x4 __attribute__((ext_vector_type(4)));
typedef float f32x16 __attribute__((ext_vector_type(16)));
typedef unsigned u32x4 __attribute__((ext_vector_type(4)));
typedef unsigned u32x2 __attribute__((ext_vector_type(2)));
using pg8::pk_bf16; using pg8::bf_lo; using pg8::bf_hi;

constexpr int MTOK = 16384, DM = 1024, SEQ = 2048, DFF = 2816, NTHR = 512;
constexpr int LDS_BYTES = 131072 + 16;
constexpr float EPS = 1e-6f;
constexpr size_t OFF_W13A = 0, OFF_W2A = 11534336, OFF_W13B = 17301504, OFF_W2B = 28835840, OFF_WIN = 34603008, OFF_WCO = 51380224, OFF_WAO = 53477376, OFF_WO = 55574528;
constexpr size_t OFF_HB = 57671680, OFF_TAB = OFF_HB + 33554432, OFF_RB = OFF_TAB + 131072;
constexpr size_t OFF_AB = OFF_RB, OFF_YF1 = OFF_RB + 92274688;
constexpr size_t OFF_TCH = OFF_RB, OFF_BB = OFF_RB + 33554432;
constexpr int QK_LD = 2048 + 128, VT_LD = 16384 + 128;
constexpr size_t OFF_QK = OFF_RB, OFF_VT = OFF_QK + (size_t)MTOK * QK_LD * 2, OFF_GL = OFF_VT + (size_t)1024 * VT_LD * 2, OFF_CB = OFF_GL + 67108864;
constexpr size_t OFF_M1 = OFF_QK, OFF_MB = OFF_VT, OFF_YF2 = OFF_GL, OFF_OB = OFF_HB;
constexpr size_t OFF_BAR = OFF_CB + 33554432;
constexpr size_t OFF_CNT = OFF_BAR + 16384;
constexpr size_t OFF_CEN = OFF_CNT + 16384;
constexpr size_t OFF_SLOT = OFF_CEN + 4096;
constexpr size_t WS_NEED = OFF_SLOT + 524288;

struct Params {
    const float* x; const float* w_in; const float* b_gate; const float* conv_w; const float* w_conv_out; const float* w_attn_out; const float* lam_vec; const float* subln_w;
    const float* w_o; const float* ffn1_w13; const float* ffn1_w2; const float* ffn2_w13; const float* ffn2_w2; const float* norm_w; float* out; unsigned char* ws;
};

typedef const __attribute__((address_space(4))) Params* KPtr_;
__device__ __forceinline__ void convert_weights(KPtr_ kp, int l, int t0, int t1, int bi, int nb) {
    Params p; p.ffn1_w13 = kp->ffn1_w13; p.ffn1_w2 = kp->ffn1_w2; p.ffn2_w13 = kp->ffn2_w13; p.ffn2_w2 = kp->ffn2_w2; p.w_in = kp->w_in; p.w_conv_out = kp->w_conv_out; p.w_attn_out = kp->w_attn_out; p.w_o = kp->w_o; unsigned char* ws = kp->ws;
    const int tid = opaque_tid(), n = tid & 63, kq = tid >> 6;
    for (int t = t0 + bi; t < t1; t += nb) {
        const float* src; bf16_t* dst; int K, ld, mode, tl;
        if (t < 352)       { tl = t;        src = p.ffn1_w13 + (size_t)l * 1024 * 5632; dst = (bf16_t*)(ws + OFF_W13A); K = 1024; ld = 5632; mode = 1; }
        else if (t < 528)  { tl = t - 352;  src = p.ffn1_w2 + (size_t)l * 2816 * 1024;  dst = (bf16_t*)(ws + OFF_W2A);  K = 2816; ld = 1024; mode = 0; }
        else if (t < 880)  { tl = t - 528;  src = p.ffn2_w13 + (size_t)l * 1024 * 5632; dst = (bf16_t*)(ws + OFF_W13B); K = 1024; ld = 5632; mode = 1; }
        else if (t < 1056) { tl = t - 880;  src = p.ffn2_w2 + (size_t)l * 2816 * 1024;  dst = (bf16_t*)(ws + OFF_W2B);  K = 2816; ld = 1024; mode = 0; }
        else if (t < 1568) { tl = t - 1056; src = p.w_in + (size_t)l * 1024 * 8192;     dst = (bf16_t*)(ws + OFF_WIN);  K = 1024; ld = 8192; mode = 2; }
        else if (t < 1632) { tl = t - 1568; src = p.w_conv_out + (size_t)l * 1048576;   dst = (bf16_t*)(ws + OFF_WCO);  K = 1024; ld = 1024; mode = 0; }
        else if (t < 1696) { tl = t - 1632; src = p.w_attn_out + (size_t)l * 1048576;   dst = (bf16_t*)(ws + OFF_WAO);  K = 1024; ld = 1024; mode = 0; }
        else               { tl = t - 1696; src = p.w_o + (size_t)l * 1048576;          dst = (bf16_t*)(ws + OFF_WO);   K = 1024; ld = 1024; mode = 0; }
        const int KT = K / 256, nb = tl / KT, kb = tl % KT, n0 = nb * 64; int src0 = n0;
        if (mode == 1) { const int pn = n0 >> 8, bj = (n0 >> 7) & 1, jj = n0 & 127; src0 = bj * DFF + pn * 128 + jj; }
        if (mode == 2) {
            if (n0 < 2048) { const int pn = n0 >> 8, bj = (n0 >> 7) & 1, jj = n0 & 127; src0 = 1024 + bj * 1024 + pn * 128 + jj; }
            else if (n0 < 3072) src0 = n0 - 2048;
            else src0 = (n0 < 5120) ? n0 : (n0 < 7168 ? n0 + 1024 : n0 - 2048); }
        const int k0 = kb * 256 + kq * 32;
        const float* sp = src + (size_t)k0 * ld + src0 + n;
        float v[32];
#pragma unroll
        for (int j = 0; j < 32; ++j) v[j] = sp[(size_t)j * ld];
        bf16_t* dp = dst + (size_t)(n0 + n) * K + k0;
#pragma unroll
        for (int q = 0; q < 4; ++q) { u32x4 w; w.x = pk_bf16(v[8 * q], v[8 * q + 1]); w.y = pk_bf16(v[8 * q + 2], v[8 * q + 3]); w.z = pk_bf16(v[8 * q + 4], v[8 * q + 5]); w.w = pk_bf16(v[8 * q + 6], v[8 * q + 7]);
            *(u32x4*)(dp + 8 * q) = w; }
    }
}
__device__ __forceinline__ void rope_tables(float* cs, float* sn) {
    for (int i = blockIdx.x * NTHR + opaque_tid(); i < SEQ * 8; i += gridDim.x * NTHR) {
        const int pos = i >> 3, j = i & 7;
        const float inv = (float)pow(500000.0, -(double)j / 8.0);
        const float ang = (float)pos * inv;
        cs[i] = (float)cos((double)ang); sn[i] = (float)sin((double)ang);
    }
}

__device__ __forceinline__ float sum16(float v) { v += __shfl_xor(v, 8); v += __shfl_xor(v, 4); v += __shfl_xor(v, 2); v += __shfl_xor(v, 1); return v; }
template <int MODE> __device__ __forceinline__ void row_phase(const float* xin, float* x, const bf16_t* y, const float* wpost, float scale, const float* wpre, bf16_t* h) {
    const int tid = opaque_tid(), lane = tid & 63, wid = tid >> 6, sub = lane >> 4, l16 = lane & 15;
    for (int row = (blockIdx.x * 8 + wid) * 4 + sub; row < MTOK; row += gridDim.x * 32) {
        const size_t ro = (size_t)row * DM + l16 * 4;
        f32x4 xv[16];
        if (MODE == 0 || MODE == 3) {
#pragma unroll
            for (int i = 0; i < 16; ++i) xv[i] = *(const f32x4*)(xin + ro + i * 64);
        } else {
            f32x4 yv[16]; float ss = 0.f;
#pragma unroll
            for (int i = 0; i < 16; ++i) { const u32x2 yw = *(const u32x2*)(y + ro + i * 64); yv[i] = (f32x4){bf_lo(yw.x), bf_hi(yw.x), bf_lo(yw.y), bf_hi(yw.y)}; xv[i] = *(const f32x4*)(x + ro + i * 64); }
#pragma unroll
            for (int i = 0; i < 16; ++i) ss += yv[i][0] * yv[i][0] + yv[i][1] * yv[i][1] + yv[i][2] * yv[i][2] + yv[i][3] * yv[i][3];
            ss = sum16(ss); const float rs = scale * __builtin_amdgcn_rsqf(ss * (1.0f / DM) + EPS);
#pragma unroll
            for (int i = 0; i < 16; ++i) { const f32x4 w = *(const f32x4*)(wpost + l16 * 4 + i * 64); xv[i] += yv[i] * rs * w; }
        }
        if (MODE != 3) {
#pragma unroll
            for (int i = 0; i < 16; ++i) *(f32x4*)(x + ro + i * 64) = xv[i]; }
        if (MODE != 2) {
            float ss = 0.f;
#pragma unroll
            for (int i = 0; i < 16; ++i) ss += xv[i][0] * xv[i][0] + xv[i][1] * xv[i][1] + xv[i][2] * xv[i][2] + xv[i][3] * xv[i][3];
            ss = sum16(ss); const float rs = __builtin_amdgcn_rsqf(ss * (1.0f / DM) + EPS);
#pragma unroll
            for (int i = 0; i < 16; ++i) { const f32x4 w = *(const f32x4*)(wpre + l16 * 4 + i * 64); const f32x4 v = xv[i] * rs * w;
                u32x2 o; o.x = pk_bf16(v[0], v[1]); o.y = pk_bf16(v[2], v[3]); *(u32x2*)(h + ro + i * 64) = o; }
        }
    }
}

__device__ __forceinline__ void ld8(const bf16_t* p, float (&v)[8]) { const u32x4 w = *(const u32x4*)p; v[0] = bf_lo(w.x); v[1] = bf_hi(w.x); v[2] = bf_lo(w.y); v[3] = bf_hi(w.y); v[4] = bf_lo(w.z); v[5] = bf_hi(w.z); v[6] = bf_lo(w.w); v[7] = bf_hi(w.w); }
__device__ __forceinline__ void conv_phase(const bf16_t* tb, const bf16_t* bb, const float* cw, bf16_t* cb) {
    for (int item = blockIdx.x * NTHR + opaque_tid(); item < 262144; item += gridDim.x * NTHR) {
        const int cgp = item & 127, chunk = item >> 7, c0 = cgp * 8, tok0 = chunk * 8, s0 = tok0 & (SEQ - 1);
        u32x4 tr[10], br[8];
        const u32x4 z4 = {0u, 0u, 0u, 0u};
#pragma unroll
        for (int i = 0; i < 10; ++i) { const int s = s0 - 1 + i; const bool ok = (s >= 0) && (s < SEQ); tr[i] = ok ? *(const u32x4*)(tb + (size_t)(tok0 - 1 + i) * DM + c0) : z4; }
#pragma unroll
        for (int i = 0; i < 8; ++i) br[i] = *(const u32x4*)(bb + (size_t)(tok0 + i) * DM + c0);
        float w0[8], w1[8], w2[8];
#pragma unroll
        for (int j = 0; j < 8; ++j) { w0[j] = cw[c0 + j]; w1[j] = cw[1024 + c0 + j]; w2[j] = cw[2048 + c0 + j]; }
        float tp[8], tc[8], tn[8];
#define CONV_T(dst, i) do { const u32x4 a_ = tr[i]; dst[0] = bf_lo(a_.x); dst[1] = bf_hi(a_.x); dst[2] = bf_lo(a_.y); dst[3] = bf_hi(a_.y); dst[4] = bf_lo(a_.z); dst[5] = bf_hi(a_.z); dst[6] = bf_lo(a_.w); dst[7] = bf_hi(a_.w); } while (0)
        CONV_T(tp, 0); CONV_T(tc, 1);
#pragma unroll
        for (int i = 0; i < 8; ++i) {
            CONV_T(tn, i + 2);
            const u32x4 bw = br[i]; const float bv[8] = {bf_lo(bw.x), bf_hi(bw.x), bf_lo(bw.y), bf_hi(bw.y), bf_lo(bw.z), bf_hi(bw.z), bf_lo(bw.w), bf_hi(bw.w)};
            float o[8];
#pragma unroll
            for (int j = 0; j < 8; ++j) { o[j] = bv[j] * (w0[j] * tp[j] + w1[j] * tc[j] + w2[j] * tn[j]); tp[j] = tc[j]; tc[j] = tn[j]; }
            u32x4 w; w.x = pk_bf16(o[0], o[1]); w.y = pk_bf16(o[2], o[3]); w.z = pk_bf16(o[4], o[5]); w.w = pk_bf16(o[6], o[7]);
            *(u32x4*)(cb + (size_t)(tok0 + i) * DM + c0) = w;
        }
#undef CONV_T
    }
}

#ifndef ATT_SCHED
#define ATT_SCHED 0
#endif
__device__ __forceinline__ float fmax3(float a, float b, float c) { return fmaxf(fmaxf(a, b), c); }
__device__ __forceinline__ void attn_phase(LAS unsigned char* lds, const bf16_t* qk, const bf16_t* vt, bf16_t* ob, const float* lv, const float* subln, float lam_init, int vcb) {
    const int tid = opaque_tid(), wid = __builtin_amdgcn_readfirstlane(tid >> 6), lane = tid & 63, r = lane & 31, hf = lane >> 5;
    const int c = wid >> 2, qw = wid & 3;
    float d1 = 0.f, d2 = 0.f;
    for (int i = 0; i < 64; ++i) { d1 += lv[i] * lv[64 + i]; d2 += lv[128 + i] * lv[192 + i]; }
    const float lam = expf(d1) - expf(d2) + lam_init;
    const float C2 = 0.125f * 1.44269504f;
    const int G = gridDim.x, cb = vcb;
    const int pr = (r & ~12) | ((r & 4) << 1) | ((r & 8) >> 1);
    const int ksw = (pr >> 1) & 7, vsw = (r >> 1) & 7;
    const int srow = tid >> 3, sch = tid & 7;
    for (int it = 0;; ++it) {
        const int u = it * G + cb; if (u >= 1024) break;
        int bh, qb;
        if (G == 256) { bh = it * 16 + (cb & 7) * 2 + (cb >> 7); qb = (cb >> 3) & 15; } else { bh = u >> 4; qb = u & 15; }
        const int b = bh >> 3, h = bh & 7;
        const size_t tok0 = (size_t)b * SEQ;
        const size_t qtok = tok0 + qb * 128 + qw * 32 + r;
        const bf16_t* qrow = qk + qtok * QK_LD + h * 128 + c * 64 + 8 * hf;
        bf16x8 Qf[4];
#pragma unroll
        for (int kk = 0; kk < 4; ++kk) Qf[kk] = *(const bf16x8*)(qrow + 16 * kk);
        f32x16 O[4];
#pragma unroll
        for (int d = 0; d < 4; ++d)
#pragma unroll
            for (int i = 0; i < 16; ++i) O[d][i] = 0.f;
        float mrun = -1e30f, lrun = 0.f;
        const int gch = sch ^ ((srow >> 1) & 7);
        const bf16_t* kg = qk + (tok0 + srow) * QK_LD + 1024 + h * 128 + gch * 8;
        const bf16_t* vg = vt + (size_t)(h * 128 + srow) * VT_LD + tok0 + gch * 8;
#define ATT_ISSUE(t) do { const int tt_ = ((t) + 2 * qb) & 31; LAS unsigned char* bs = lds + ((t) & 3) * 32768 + wid * 1024; \
            __builtin_amdgcn_global_load_lds((const unsigned*)(kg + (size_t)tt_ * 64 * QK_LD), (LAS unsigned*)(bs), 16, 0, 0); \
            __builtin_amdgcn_global_load_lds((const unsigned*)(kg + (size_t)tt_ * 64 * QK_LD + 64), (LAS unsigned*)(bs + 8192), 16, 0, 0); \
            __builtin_amdgcn_global_load_lds((const unsigned*)(vg + tt_ * 64), (LAS unsigned*)(bs + 16384), 16, 0, 0); \
            __builtin_amdgcn_global_load_lds((const unsigned*)(vg + tt_ * 64 + (size_t)64 * VT_LD), (LAS unsigned*)(bs + 24576), 16, 0, 0); } while (0)
#define ATT_KLD(buf) do { const LAS unsigned char* kb_ = lds + (buf) * 32768 + c * 8192 + pr * 128; \
            _Pragma("unroll") for (int kk = 0; kk < 4; ++kk) { const int off = ((2 * kk + hf) ^ ksw) << 4; Kf[kk] = *(const LAS bf16x8*)(kb_ + off); Kf[4 + kk] = *(const LAS bf16x8*)(kb_ + 32 * 128 + off); } } while (0)
#define ATT_QKM(D0, D1) do { _Pragma("unroll") for (int i = 0; i < 16; ++i) { D0[i] = 0.f; D1[i] = 0.f; } \
            _Pragma("unroll") for (int kk = 0; kk < 4; ++kk) { D0 = __builtin_amdgcn_mfma_f32_32x32x16_bf16(Kf[kk], Qf[kk], D0, 0, 0, 0); D1 = __builtin_amdgcn_mfma_f32_32x32x16_bf16(Kf[4 + kk], Qf[kk], D1, 0, 0, 0); } } while (0)
#define ATT_VLD(DST, buf, d0) do { const LAS unsigned char* vb_ = lds + (buf) * 32768 + 16384 + r * 128; \
            _Pragma("unroll") for (int dd = 0; dd < 2; ++dd) _Pragma("unroll") for (int kb = 0; kb < 2; ++kb) _Pragma("unroll") for (int s = 0; s < 2; ++s) \
                DST[dd * 4 + kb * 2 + s] = *(const LAS bf16x8*)(vb_ + ((d0) + dd) * 32 * 128 + (((4 * kb + 2 * s + hf) ^ vsw) << 4)); } while (0)
#define ATT_PVM(SRC, d0) do { _Pragma("unroll") for (int kb = 0; kb < 2; ++kb) _Pragma("unroll") for (int s = 0; s < 2; ++s) _Pragma("unroll") for (int dd = 0; dd < 2; ++dd) \
                O[(d0) + dd] = __builtin_amdgcn_mfma_f32_32x32x16_bf16(SRC[dd * 4 + kb * 2 + s], P[kb][s], O[(d0) + dd], 0, 0, 0); } while (0)
#define ATT_BAR() do { asm volatile("" ::: "memory"); __builtin_amdgcn_s_barrier(); asm volatile("" ::: "memory"); } while (0)
#define ATT_SB() __builtin_amdgcn_sched_barrier(0)
        ATT_ISSUE(0); ATT_ISSUE(1); if (c == 0) ATT_ISSUE(2);
        asm volatile("s_waitcnt vmcnt(0)" ::: "memory"); ATT_BAR();
        f32x16 S0, S1;
        bf16x8 Kf[8], VA[8];
        bf16x8 P[2][2];
        ATT_KLD(0); ATT_QKM(S0, S1);
#define ATT_PV(buf) do { ATT_VLD(VA, (buf), 0); ATT_SB(); ATT_PVM(VA, 0); ATT_SB(); ATT_VLD(VA, (buf), 2); ATT_SB(); ATT_PVM(VA, 2); ATT_SB(); } while (0)
        for (int t = 0; t < 32; ++t) {
            if (c == 1 && t < 30) ATT_ISSUE(t + 2);
            if (t > 0) ATT_PV((t - 1) & 3);
            if (c == 0) { asm volatile("s_waitcnt vmcnt(0)" ::: "memory"); ATT_BAR(); if (t < 29) ATT_ISSUE(t + 3); }
            ATT_KLD((t + 1) & 3);
            ATT_SB();
            float tm = fmaxf(S0[0], S1[0]);
#pragma unroll
            for (int i = 1; i < 16; ++i) tm = fmax3(tm, S0[i], S1[i]);
            tm = fmaxf(tm, __shfl_xor(tm, 32));
            const bool upd = tm > mrun + 64.0f;
            const float mn = upd ? tm : mrun, alpha = __builtin_amdgcn_exp2f((mrun - mn) * C2), mc = mn * C2;
            mrun = mn;
            if (__builtin_amdgcn_ballot_w64(upd) != 0ull) {
#pragma unroll
                for (int d = 0; d < 4; ++d)
#pragma unroll
                    for (int i = 0; i < 16; ++i) O[d][i] *= alpha;
            }
            ATT_SB();
            f32x16 N0, N1;
            ATT_QKM(N0, N1);
            float rs = 0.f;
#pragma unroll
            for (int i = 0; i < 16; ++i) { S0[i] = __builtin_amdgcn_exp2f(S0[i] * C2 - mc); S1[i] = __builtin_amdgcn_exp2f(S1[i] * C2 - mc); rs += S0[i] + S1[i]; }
            lrun = lrun * alpha + rs;
#pragma unroll
            for (int s = 0; s < 2; ++s) {
                u32x4 w0, w1;
                w0.x = pk_bf16(S0[8 * s + 0], S0[8 * s + 1]); w0.y = pk_bf16(S0[8 * s + 2], S0[8 * s + 3]); w0.z = pk_bf16(S0[8 * s + 4], S0[8 * s + 5]); w0.w = pk_bf16(S0[8 * s + 6], S0[8 * s + 7]);
                w1.x = pk_bf16(S1[8 * s + 0], S1[8 * s + 1]); w1.y = pk_bf16(S1[8 * s + 2], S1[8 * s + 3]); w1.z = pk_bf16(S1[8 * s + 4], S1[8 * s + 5]); w1.w = pk_bf16(S1[8 * s + 6], S1[8 * s + 7]);
                P[0][s] = __builtin_bit_cast(bf16x8, w0); P[1][s] = __builtin_bit_cast(bf16x8, w1);
            }
            ATT_SB();
            if (c == 1) { asm volatile("s_waitcnt vmcnt(0)" ::: "memory"); ATT_BAR(); }
            S0 = N0; S1 = N1;
        }
        ATT_PV(31 & 3);
#undef ATT_PV
#undef ATT_KLD
#undef ATT_QKM
#undef ATT_VLD
#undef ATT_PVM
#undef ATT_ISSUE
        const float lt = lrun + __shfl_xor(lrun, 32);
        LAS float* X = (LAS float*)lds + qw * 4096 + lane;
        if (c == 1) { const float sc = lam / lt;
#pragma unroll
            for (int d = 0; d < 4; ++d)
#pragma unroll
                for (int i = 0; i < 16; ++i) X[(d * 16 + i) * 64] = O[d][i] * sc; }
        __syncthreads();
        if (c == 0) { const float sc = 1.0f / lt; float ss = 0.f;
#pragma unroll
            for (int d = 0; d < 4; ++d)
#pragma unroll
                for (int i = 0; i < 16; ++i) { const float o = O[d][i] * sc - X[(d * 16 + i) * 64]; O[d][i] = o; ss += o * o; }
            ss += __shfl_xor(ss, 32);
            const float rms = __builtin_amdgcn_rsqf(ss * (1.0f / 128.0f) + EPS) * (1.0f - lam_init);
            bf16_t* orow = ob + qtok * DM + h * 128 + 4 * hf;
#pragma unroll
            for (int d = 0; d < 4; ++d)
#pragma unroll
                for (int g = 0; g < 4; ++g) { const int dv = 32 * d + 8 * g;
                    const f32x4 w = *(const f32x4*)(subln + dv + 4 * hf);
                    u32x2 o; o.x = pk_bf16(O[d][4 * g] * rms * w[0], O[d][4 * g + 1] * rms * w[1]); o.y = pk_bf16(O[d][4 * g + 2] * rms * w[2], O[d][4 * g + 3] * rms * w[3]);
                    *(u32x2*)(orow + dv) = o; } }
        __syncthreads();
    }
}
#define XB_TMO      128
#define XB_XCNT(j)  (256  + 64 * (j))
#define XB_XSUB(j)  (1280 + 64 * (j))
#define XB_XGEN(j)  (2304 + 64 * (j))
#define XB_TOP      3328
#define XB_TOPGEN   3392
#define XCD_BAR_WORDS 3456
#define XB_SPIN_CAP (1u << 18)

__device__ __forceinline__ unsigned xb_ld(unsigned* p)              { return __hip_atomic_load(p, __ATOMIC_RELAXED, __HIP_MEMORY_SCOPE_AGENT); }
__device__ __forceinline__ unsigned xb_add(unsigned* p, unsigned v) { return __hip_atomic_fetch_add(p, v, __ATOMIC_RELAXED, __HIP_MEMORY_SCOPE_AGENT); }
__device__ __forceinline__ unsigned xb_xcc_id() { return (unsigned)__builtin_amdgcn_s_getreg((3 << 11) | 20) & 0xFu; }
#define XB_SPIN(cond, bar) do { unsigned _sp = 0; while (cond) { __builtin_amdgcn_s_sleep(1); \
    if ((++_sp & 255u) == 0u) { if (xb_ld(&(bar)[XB_TMO])) break; if (_sp > XB_SPIN_CAP) { atomicAdd(&(bar)[XB_TMO], 1u); break; } } } } while (0)

struct XcdBarrier {
    unsigned* bar; unsigned x;
    volatile LAS unsigned* st;
};

__device__ __forceinline__ XcdBarrier xcd_barrier_post(unsigned* bar, volatile LAS unsigned* st) {
    XcdBarrier b; b.bar = bar; b.x = xb_xcc_id(); b.st = st;
    if (threadIdx.x == 0) (void)xb_add(&bar[XB_XCNT(b.x)], 1u);
    return b;
}
__device__ __forceinline__ void xcd_barrier_complete(unsigned* bar, unsigned x, unsigned& nloc, unsigned& nx) {
    const unsigned G = gridDim.x * gridDim.y * gridDim.z;
    unsigned sum, cnt, mine, sp = 0u;
    for (;;) {
        sum = 0u; cnt = 0u; mine = 0u;
#pragma unroll
        for (unsigned j = 0; j < 16; ++j) { const unsigned c = xb_ld(&bar[XB_XCNT(j)]); sum += c; cnt += (c > 0u) ? 1u : 0u; mine = (j == x) ? c : mine; }
        if (sum == G) break;
        __builtin_amdgcn_s_sleep(1);
        if ((++sp & 255u) == 0u) { if (xb_ld(&bar[XB_TMO])) break; if (sp > XB_SPIN_CAP) { atomicAdd(&bar[XB_TMO], 1u); break; } }
    }
    nloc = mine > 0u ? mine : 1u; nx = cnt > 0u ? cnt : 1u;
}

__device__ __forceinline__ void xcd_barrier(const XcdBarrier& b) {
    asm volatile("s_waitcnt vmcnt(0)" ::: "memory");
    __syncthreads();
    if (threadIdx.x == 0) {
        unsigned* bar = b.bar;
        __builtin_amdgcn_s_waitcnt(0);
        unsigned nloc = b.st[0], nx = b.st[1];
        if (nloc == 0u) { xcd_barrier_complete(bar, b.x, nloc, nx); b.st[0] = nloc; b.st[1] = nx; }
        const unsigned old = xb_add(&bar[XB_XSUB(b.x)], 1u);
        const unsigned gen = old / nloc;
        if (old + 1u == (gen + 1u) * nloc) {
            __builtin_amdgcn_fence(__ATOMIC_RELEASE, "agent");
            asm volatile("s_waitcnt vmcnt(0)" ::: "memory");
            const unsigned og = xb_add(&bar[XB_TOP], 1u);
            const unsigned tg = og / nx;
            if (og + 1u == (tg + 1u) * nx) xb_add(&bar[XB_TOPGEN], 1u);
            else XB_SPIN(xb_ld(&bar[XB_TOPGEN]) == tg, bar);
            __builtin_amdgcn_fence(__ATOMIC_ACQUIRE, "agent");
            xb_add(&bar[XB_XGEN(b.x)], 1u);
            asm volatile("s_waitcnt vmcnt(0)" ::: "memory");
        } else {
            XB_SPIN(xb_ld(&bar[XB_XGEN(b.x)]) == gen, bar);
            __builtin_amdgcn_fence(__ATOMIC_ACQUIRE, "agent");
            asm volatile("s_waitcnt vmcnt(0)" ::: "memory");
        }
    }
    __syncthreads();
}
#ifndef REP_GEMM
#define REP_GEMM 1
#endif
#ifndef REP_ATTN
#define REP_ATTN 1
#endif
#ifndef REP_CONV
#define REP_CONV 1
#endif
#ifndef REP_CVT
#define REP_CVT 1
#endif
#ifndef REP_SYNC
#define REP_SYNC 1
#endif
#define GSYNC() do { for (int rep_ = 0; rep_ < REP_SYNC; ++rep_) xcd_barrier(bar); } while (0)
template <class Epi> __device__ __forceinline__ void run_gemm2_(LAS unsigned char* lds, const bf16_t* A0, const bf16_t* B0, int M0, int N0, const bf16_t* A1, const bf16_t* B1, int M1, int N1, int K, const Epi& E, int vcb) {
    pg8::Gemm g{A0, B0, M0, N0, K, A1, B1}; pg8::DualOrder S; S.init(M0, N0, M1, N1, (int)gridDim.x, vcb);
    for (int rep = 0; rep < REP_GEMM; ++rep) pg8::gemm_phase<Epi, pg8::DualOrder, true, true>(lds, g, S, E);
}
template <class Epi> __device__ __forceinline__ void run_gemm_(LAS unsigned char* lds, const bf16_t* A, const bf16_t* Bt, int M, int N, int K, const Epi& E, int vcb) {
    pg8::Gemm g{A, Bt, M, N, K, nullptr, nullptr}; pg8::StaticOrder S; S.init(M, N, (int)gridDim.x, vcb);
    for (int rep = 0; rep < REP_GEMM; ++rep) pg8::gemm_phase<Epi, pg8::StaticOrder, !Epi::AFTER_DRAIN, true>(lds, g, S, E);
}

typedef const __attribute__((address_space(4))) Params* KPtr;
__device__ __forceinline__ KPtr kparams() { KPtr kp = (KPtr)__builtin_amdgcn_kernarg_segment_ptr(); asm volatile("" : "+s"(kp)); return kp; }
#define WSP(T, off) ((T*)(kparams()->ws + (off)))
__device__ __forceinline__ int vcb_read(LAS unsigned char* lds) { unsigned off = 131072u + 8u; asm volatile("" : "+v"(off)); return (int)__builtin_amdgcn_readfirstlane(*(volatile LAS unsigned*)(lds + off)); }
#define VCB() vcb_read(lds)
#define run_gemm(...) run_gemm_(__VA_ARGS__, VCB())
#define run_gemm2(...) run_gemm2_(__VA_ARGS__, VCB())
template <bool fusedn> __global__ void __launch_bounds__(NTHR) fwd_megakernel(Params p_unused) {
    extern __shared__ __attribute__((aligned(16))) unsigned char smem[];
    cg::grid_group grid = cg::this_grid();
    LAS unsigned char* lds = (LAS unsigned char*)smem;
    if (threadIdx.x < 4) ((LAS unsigned*)(lds + 131072))[threadIdx.x] = 0u;
    __syncthreads();
    const XcdBarrier bar = xcd_barrier_post(WSP(unsigned, OFF_BAR), (volatile LAS unsigned*)(lds + 131072));
    if (threadIdx.x == 0) { unsigned* cen = WSP(unsigned, OFF_CEN); ((volatile LAS unsigned*)(lds + 131072))[3] = __hip_atomic_fetch_add(cen + 64 * bar.x, 1u, __ATOMIC_RELAXED, __HIP_MEMORY_SCOPE_AGENT); }

    { const KPtr kp = kparams(); for (int rep = 0; rep < REP_CVT; ++rep) convert_weights(kp, 0, 0, 528, (int)blockIdx.x, (int)gridDim.x); }
    rope_tables(WSP(float, OFF_TAB), WSP(float, OFF_TAB) + SEQ * 8);
    { const KPtr kp = kparams(); if constexpr (fusedn) row_phase<3>(kp->x, nullptr, nullptr, nullptr, 0.f, kp->norm_w, WSP(bf16_t, OFF_HB)); else row_phase<0>(kp->x, kp->out, nullptr, nullptr, 0.f, kp->norm_w, WSP(bf16_t, OFF_HB)); }
    grid.sync();
    if (threadIdx.x == 0) { unsigned* cen = WSP(unsigned, OFF_CEN); const unsigned per = gridDim.x >> 3; bool ok = (gridDim.x & 7u) == 0u && bar.x < 8u;
        for (int j = 0; j < 8; ++j) ok = ok && (__hip_atomic_load(cen + 64 * j, __ATOMIC_RELAXED, __HIP_MEMORY_SCOPE_AGENT) == per);
        volatile LAS unsigned* w = (volatile LAS unsigned*)(lds + 131072); w[2] = ok ? (w[3] * 8u + bar.x) : blockIdx.x; }
    __syncthreads();
    for (int l = 0; l < 2; ++l) {
        run_gemm(lds, WSP(bf16_t, OFF_HB), WSP(bf16_t, OFF_W13A), MTOK, 2 * DFF, DM, pg8::EpiGlu<true>{WSP(bf16_t, OFF_AB), DFF});
        { const int rem = 1408 % (int)gridDim.x, vc = VCB(); const KPtr kp = kparams();
          if (rem == 0) convert_weights(kp, l, 528, 1760, vc, (int)gridDim.x); else if (vc >= rem) convert_weights(kp, l, 528, 1760, vc - rem, (int)gridDim.x - rem); }
        GSYNC();
        if constexpr (fusedn) { const KPtr kp = kparams(); const float* nw = kp->norm_w + (size_t)l * 6 * DM;
            run_gemm(lds, WSP(bf16_t, OFF_AB), WSP(bf16_t, OFF_W2A), MTOK, DM, DFF, pg8::EpiNormRes{l == 0 ? kp->x : kp->out, kp->out, nw + DM, 0.5f, nw + 2 * DM, WSP(bf16_t, OFF_HB), WSP(float, OFF_SLOT), WSP(unsigned, OFF_CNT), (unsigned)(l * 6)}); }
        else { run_gemm(lds, WSP(bf16_t, OFF_AB), WSP(bf16_t, OFF_W2A), MTOK, DM, DFF, pg8::EpiBf16{WSP(bf16_t, OFF_YF1), DM, 0, nullptr, 0, nullptr, nullptr, 0}); GSYNC();
            const KPtr kp = kparams(); const float* nw = kp->norm_w + (size_t)l * 6 * DM; row_phase<1>(nullptr, kp->out, WSP(bf16_t, OFF_YF1), nw + DM, 0.5f, nw + 2 * DM, WSP(bf16_t, OFF_HB)); }
        GSYNC();
        { typedef pg8::EpiSplitN<pg8::EpiGlu<false>, pg8::EpiBf16> EpiTB;
          run_gemm(lds, WSP(bf16_t, OFF_HB), WSP(bf16_t, OFF_WIN), MTOK, 3072, DM, EpiTB{pg8::EpiGlu<false>{WSP(bf16_t, OFF_TCH), DM}, pg8::EpiBf16{WSP(bf16_t, OFF_BB), DM, 0, nullptr, 0, nullptr, nullptr, 0}, 8}); }
        GSYNC();
        for (int rep = 0; rep < REP_CONV; ++rep) conv_phase(WSP(bf16_t, OFF_TCH), WSP(bf16_t, OFF_BB), kparams()->conv_w + (size_t)l * 3 * DM, WSP(bf16_t, OFF_CB));
        GSYNC();
        { typedef pg8::EpiSel<pg8::EpiBf16, pg8::EpiBf16> EpiQV;
          run_gemm2(lds, WSP(bf16_t, OFF_HB), WSP(bf16_t, OFF_WIN) + (size_t)3072 * DM, MTOK, 4096, WSP(bf16_t, OFF_WIN) + (size_t)7168 * DM, WSP(bf16_t, OFF_HB), DM, MTOK, DM,
                    EpiQV{pg8::EpiBf16{WSP(bf16_t, OFF_QK), QK_LD, 8, WSP(bf16_t, OFF_GL), 8, WSP(float, OFF_TAB), WSP(float, OFF_TAB) + SEQ * 8, 2048},
                          pg8::EpiBf16{WSP(bf16_t, OFF_VT), VT_LD, 0, nullptr, 0, nullptr, nullptr, 0}}); }
        GSYNC();
        { const KPtr kp = kparams(); const float lam_init = 0.8f - 0.6f * expf(-0.3f * (float)l);
          for (int rep = 0; rep < REP_ATTN; ++rep) attn_phase(lds, WSP(bf16_t, OFF_QK), WSP(bf16_t, OFF_VT), WSP(bf16_t, OFF_OB), kp->lam_vec + (size_t)l * 256, kp->subln_w + (size_t)l * 128, lam_init, VCB()); }
        GSYNC();
        { const KPtr kp = kparams(); const float* bgp = kp->b_gate + (size_t)l * 2048;
          const pg8::EpiGate<1> e1{WSP(bf16_t, OFF_GL), 2048, bgp, WSP(bf16_t, OFF_M1), WSP(bf16_t, OFF_MB), DM};
          const pg8::EpiGate<2> e2{WSP(bf16_t, OFF_GL) + 1024, 2048, bgp + 1024, WSP(bf16_t, OFF_M1), WSP(bf16_t, OFF_MB), DM};
          if constexpr (fusedn) { typedef pg8::EpiSel<pg8::EpiGate<1>, pg8::EpiGate<2>> EpiG;
              run_gemm2(lds, WSP(bf16_t, OFF_CB), WSP(bf16_t, OFF_WCO), MTOK, DM, WSP(bf16_t, OFF_OB), WSP(bf16_t, OFF_WAO), MTOK, DM, DM, EpiG{e1, e2}); }
          else { run_gemm(lds, WSP(bf16_t, OFF_CB), WSP(bf16_t, OFF_WCO), MTOK, DM, DM, e1); run_gemm(lds, WSP(bf16_t, OFF_OB), WSP(bf16_t, OFF_WAO), MTOK, DM, DM, e2); } }
        GSYNC();
        if constexpr (fusedn) { const KPtr kp = kparams(); const float* nw = kp->norm_w + (size_t)l * 6 * DM;
            run_gemm(lds, WSP(bf16_t, OFF_MB), WSP(bf16_t, OFF_WO), MTOK, DM, DM, pg8::EpiNormRes{kp->out, kp->out, nw + 3 * DM, 1.0f, nw + 4 * DM, WSP(bf16_t, OFF_HB), WSP(float, OFF_SLOT), WSP(unsigned, OFF_CNT), (unsigned)(l * 6 + 2)}); }
        else { run_gemm(lds, WSP(bf16_t, OFF_MB), WSP(bf16_t, OFF_WO), MTOK, DM, DM, pg8::EpiBf16{WSP(bf16_t, OFF_YF2), DM, 0, nullptr, 0, nullptr, nullptr, 0}); GSYNC();
            const KPtr kp = kparams(); const float* nw = kp->norm_w + (size_t)l * 6 * DM; row_phase<1>(nullptr, kp->out, WSP(bf16_t, OFF_YF2), nw + 3 * DM, 1.0f, nw + 4 * DM, WSP(bf16_t, OFF_HB)); }
        GSYNC();
        run_gemm(lds, WSP(bf16_t, OFF_HB), WSP(bf16_t, OFF_W13B), MTOK, 2 * DFF, DM, pg8::EpiGlu<true>{WSP(bf16_t, OFF_AB), DFF});
        if (l == 0) { const int rem = 1408 % (int)gridDim.x, vc = VCB(); const KPtr kp = kparams();
          if (rem == 0) convert_weights(kp, 1, 0, 528, vc, (int)gridDim.x); else if (vc >= rem) convert_weights(kp, 1, 0, 528, vc - rem, (int)gridDim.x - rem); }
        GSYNC();
        if constexpr (fusedn) { const KPtr kp = kparams(); const float* nw = kp->norm_w + (size_t)l * 6 * DM;
            run_gemm(lds, WSP(bf16_t, OFF_AB), WSP(bf16_t, OFF_W2B), MTOK, DM, DFF, pg8::EpiNormRes{kp->out, kp->out, nw + 5 * DM, 0.5f, nw + 6 * DM, l == 0 ? WSP(bf16_t, OFF_HB) : nullptr, WSP(float, OFF_SLOT), WSP(unsigned, OFF_CNT), (unsigned)(l * 6 + 4)}); }
        else { run_gemm(lds, WSP(bf16_t, OFF_AB), WSP(bf16_t, OFF_W2B), MTOK, DM, DFF, pg8::EpiBf16{WSP(bf16_t, OFF_YF1), DM, 0, nullptr, 0, nullptr, nullptr, 0}); GSYNC();
            const KPtr kp = kparams(); const float* nw = kp->norm_w + (size_t)l * 6 * DM;
            if (l == 0) row_phase<1>(nullptr, kp->out, WSP(bf16_t, OFF_YF1), nw + 5 * DM, 0.5f, nw + 6 * DM, WSP(bf16_t, OFF_HB));
            else row_phase<2>(nullptr, kp->out, WSP(bf16_t, OFF_YF1), nw + 5 * DM, 0.5f, nullptr, nullptr); }
        if (l == 0) GSYNC();
    }
}

extern "C" void kernel_launch(void* const* d_in, const int* in_sizes, int n_in, void* d_out, int out_size, void* d_ws, size_t ws_size, hipStream_t stream) {
    static int grid_blocks = 0; static const void* kfn = nullptr;
    if (grid_blocks == 0) {
        if (ws_size < WS_NEED) { fprintf(stderr, "kernel_launch: workspace too small: %zu < %zu\n", ws_size, (size_t)WS_NEED); grid_blocks = -1; return; }
        int dev = 0, cus = 0, per_cu = 0;
        (void)hipGetDevice(&dev);
        (void)hipDeviceGetAttribute(&cus, hipDeviceAttributeMultiprocessorCount, dev);
        kfn = (cus == 256) ? (const void*)fwd_megakernel<true> : (const void*)fwd_megakernel<false>;
        if (hipFuncSetAttribute((const void*)kfn, hipFuncAttributeMaxDynamicSharedMemorySize, LDS_BYTES) != hipSuccess) { fprintf(stderr, "kernel_launch: hipFuncSetAttribute failed\n"); grid_blocks = -1; return; }
        if (hipOccupancyMaxActiveBlocksPerMultiprocessor(&per_cu, (const void*)kfn, NTHR, LDS_BYTES) != hipSuccess || per_cu < 1) { fprintf(stderr, "kernel_launch: occupancy query failed (%d)\n", per_cu); grid_blocks = -1; return; }
        grid_blocks = cus * 1;
        fprintf(stderr, "kernel_launch: cus %d per_cu %d grid %d ws %zu\n", cus, per_cu, grid_blocks, ws_size);
    }
    if (grid_blocks < 0) return;
    if (hipMemsetAsync((char*)d_ws + OFF_BAR, 0, 32768 + 4096, stream) != hipSuccess) { fprintf(stderr, "kernel_launch: memset failed\n"); return; }
    Params p{};
    p.x = (const float*)d_in[0]; p.w_in = (const float*)d_in[1]; p.b_gate = (const float*)d_in[2]; p.conv_w = (const float*)d_in[3]; p.w_conv_out = (const float*)d_in[4];
    p.w_attn_out = (const float*)d_in[5]; p.lam_vec = (const float*)d_in[6]; p.subln_w = (const float*)d_in[7]; p.w_o = (const float*)d_in[8];
    p.ffn1_w13 = (const float*)d_in[9]; p.ffn1_w2 = (const float*)d_in[10]; p.ffn2_w13 = (const float*)d_in[11]; p.ffn2_w2 = (const float*)d_in[12]; p.norm_w = (const float*)d_in[13];
    p.out = (float*)d_out; p.ws = (unsigned char*)d_ws;
    void* args[] = {&p};
    hipError_t e = hipLaunchCooperativeKernel((const void*)kfn, dim3(grid_blocks), dim3(NTHR), args, LDS_BYTES, stream);
    if (e != hipSuccess) fprintf(stderr, "cooperative launch failed: %s (grid %d)\n", hipGetErrorString(e), grid_blocks);
}
```

```cpp
#include <hip/hip_runtime.h>
#include <hip/hip_cooperative_groups.h>
#include <cstdio>
namespace cg = cooperative_groups;
__device__ __forceinline__ int opaque_tid() { int t = threadIdx.x; asm volatile("" : "+v"(t)); return t; }
namespace pg8 {
#define PG8_LAS __attribute__((address_space(3)))
typedef unsigned short bf16_t;
typedef short bf16x8 __attribute__((ext_vector_type(8)));
typedef float f32x4 __attribute__((ext_vector_type(4)));
typedef unsigned u32x4 __attribute__((ext_vector_type(4)));
constexpr int BM = 256, BK = 64, HALF = 128, HTB = HALF * BK * 2  , STAGE_BYTES = 8 * HTB, NXCD = 8, WGM = 8;

__host__ __device__ __forceinline__ int lds_byte(int r, int c) { const int st = (r >> 4) * 2 + (c >> 5), rr = r & 15, cc = c & 31, ob = rr * 64 + cc * 2; return st * 1024 + (ob ^ (((ob >> 9) & 1) << 5)); }
__host__ __device__ __forceinline__ void stage_rc(int b, int& R, int& C) { const int st = b / 1024, sb = b % 1024, swz = sb ^ (((sb >> 9) & 1) << 5); R = (st >> 1) * 16 + swz / 64; C = (st & 1) * 32 + (swz % 64) / 2; }
__host__ __device__ __forceinline__ int perm32(int rho) { const int n = rho >> 4, i = rho & 15; return 8 * (i >> 2) + 4 * n + (i & 3); }

struct Unit { int pm, pn, sel; };
struct Gemm { const bf16_t* A; const bf16_t* Bt; int M, N, K; const bf16_t* A2; const bf16_t* Bt2; };

struct StaticOrder {
    int nM, nN, nwg, G, c;
    __host__ __device__ void init(int M, int N, int G_, int c_) { nM = M / BM; nN = N / BM; nwg = nM * nN; G = G_; c = c_; }
    __host__ __device__ bool next(int i, Unit& u) const { return map((long)i * G + c, u); }
    __host__ __device__ bool map(long L, Unit& u) const {
        if (L >= nwg) return false;
        u.sel = 0;
        int wgid = (int)L; { const int q = nwg / NXCD, r = nwg % NXCD, xcd = wgid % NXCD, off = wgid / NXCD; wgid = (xcd < r ? xcd * (q + 1) : r * (q + 1) + (xcd - r) * q) + off; }
        const int nig = WGM * nN, gid = wgid / nig, fm = gid * WGM, gsz = (nM - fm) < WGM ? (nM - fm) : WGM;
        u.pm = fm + ((wgid % nig) % gsz); u.pn = (wgid % nig) / gsz; return true;
    }
    __device__ __forceinline__ void a_ready(const Unit&) const {}
    __device__ __forceinline__ void done(const Unit&) const {}
};
struct DualOrder {
    StaticOrder s0, s1; int G, c;
    __host__ __device__ void init(int M0, int N0, int M1, int N1, int G_, int c_) { s0.init(M0, N0, G_, c_); s1.init(M1, N1, G_, c_); G = G_; c = c_; }
    __host__ __device__ bool next(int i, Unit& u) const {
        long L = (long)i * G + c; if (L < s0.nwg) return s0.map(L, u);
        L -= s0.nwg; if (!s1.map(L, u)) return false; u.sel = 1; return true; }
    __device__ __forceinline__ void a_ready(const Unit&) const {}
    __device__ __forceinline__ void done(const Unit&) const {}
};

template <class Epi, class Sched, bool ALIGN_EPI = false, bool SP2 = false>
__device__ __forceinline__ void gemm_phase(PG8_LAS unsigned char* lds, const Gemm g, const Sched& S, const Epi& E) {
    const int tid = opaque_tid(), wid = __builtin_amdgcn_readfirstlane(tid >> 6), lane = tid & 63, wr = wid >> 2, wc = wid & 3, fr = lane & 15, fq = lane >> 4;
    const int K = g.K, nt = K / BK;
    unsigned voffA[2], voffB[2];
#pragma unroll
    for (int i = 0; i < 2; ++i) { int R, C; stage_rc(tid * 16 + i * 8192, R, C); const int Rb = Epi::PERM ? ((R & ~31) + perm32(R & 31)) : R;
        voffA[i] = (unsigned)(R * K + C) * 2u; voffB[i] = (unsigned)(Rb * K + C) * 2u; }
    const size_t kstep = (size_t)(BK * 2);
    const size_t hstep = (size_t)HALF * K * 2;
    const size_t tstep = 2 * hstep;
    const unsigned ldsw = (unsigned)wid * 1024u;
    const int aoff = lds_byte(wr * 64 + fr, fq * 8), boff = lds_byte(wc * 32 + fr, fq * 8);
#define PG8_SA(b, h) (((b) * 2 + (h)) * HTB)
#define PG8_SB(b, h) ((4 + (b) * 2 + (h)) * HTB)
#define PG8_STAGE(bufoff, gbase, voff) do { _Pragma("unroll") for (int _i = 0; _i < 2; ++_i) \
        __builtin_amdgcn_global_load_lds((const unsigned*)((const char*)(gbase) + (voff)[_i]), (PG8_LAS unsigned*)(lds + (bufoff) + ldsw + _i * 8192), 16, 0, 0); } while (0)
#define PG8_LDA(dst, b, h) do { _Pragma("unroll") for (int m = 0; m < 4; ++m) _Pragma("unroll") for (int k = 0; k < 2; ++k) dst[m][k] = *(const PG8_LAS bf16x8*)(lds + PG8_SA(b, h) + aoff + m * 2048 + k * 1024); } while (0)
#define PG8_LDB(dst, b, h) do { _Pragma("unroll") for (int n = 0; n < 2; ++n) _Pragma("unroll") for (int k = 0; k < 2; ++k) dst[n][k] = *(const PG8_LAS bf16x8*)(lds + PG8_SB(b, h) + boff + n * 2048 + k * 1024); } while (0)
#define PG8_MMA(ai, bj, At, Bt) do { __builtin_amdgcn_s_setprio(1); _Pragma("unroll") for (int m = 0; m < 4; ++m) _Pragma("unroll") for (int n = 0; n < 2; ++n) _Pragma("unroll") for (int k = 0; k < 2; ++k) \
        acc[ai][bj][m][n] = __builtin_amdgcn_mfma_f32_16x16x32_bf16(Bt[n][k], At[m][k], acc[ai][bj][m][n], 0, 0, 0); __builtin_amdgcn_s_setprio(0); } while (0)
#define PG8_WAIT_V(n) asm volatile("s_waitcnt vmcnt(" #n ")" ::: "memory")
#define PG8_WAIT_L(n) asm volatile("s_waitcnt lgkmcnt(" #n ")" ::: "memory")
#define PG8_BAR __builtin_amdgcn_s_barrier()
#define PG8_SCHED __builtin_amdgcn_sched_barrier(0)
    Unit cur, nxt; int ui = 0;
    if (!S.next(0, cur)) return;
    f32x4 acc[2][2][4][2];
#pragma unroll
    for (int a = 0; a < 2; ++a)
#pragma unroll
        for (int b = 0; b < 2; ++b)
#pragma unroll
            for (int m = 0; m < 4; ++m)
#pragma unroll
                for (int n = 0; n < 2; ++n) acc[a][b][m][n] = (f32x4){0.f, 0.f, 0.f, 0.f};
    bf16x8 At[4][2], B0[2][2], B1[2][2];
    const char* cA = (const char*)(cur.sel ? g.A2 : g.A) + (size_t)cur.pm * tstep; const char* cB = (const char*)(cur.sel ? g.Bt2 : g.Bt) + (size_t)cur.pn * tstep;
    S.a_ready(cur);
    if constexpr (SP2) {
        PG8_STAGE(PG8_SB(0, 0), cB, voffB); PG8_STAGE(PG8_SB(0, 1), cB + hstep, voffB); PG8_STAGE(PG8_SA(0, 0), cA, voffA); PG8_STAGE(PG8_SA(0, 1), cA + hstep, voffA);
        if (wr == 1) PG8_BAR;
        PG8_WAIT_V(2); PG8_BAR;
        PG8_STAGE(PG8_SB(1, 0), cB + kstep, voffB); PG8_STAGE(PG8_SA(1, 0), cA + kstep, voffA); PG8_STAGE(PG8_SB(1, 1), cB + hstep + kstep, voffB);
        PG8_WAIT_V(6); PG8_BAR;
    } else {
        PG8_STAGE(PG8_SB(0, 0), cB, voffB); PG8_STAGE(PG8_SA(0, 0), cA, voffA); PG8_STAGE(PG8_SB(0, 1), cB + hstep, voffB); PG8_STAGE(PG8_SA(0, 1), cA + hstep, voffA);
        if (wr == 1) PG8_BAR;
        PG8_WAIT_V(4); PG8_BAR;
        PG8_STAGE(PG8_SB(1, 0), cB + kstep, voffB); PG8_STAGE(PG8_SA(1, 0), cA + kstep, voffA); PG8_STAGE(PG8_SB(1, 1), cB + hstep + kstep, voffB);
        PG8_WAIT_V(6); PG8_BAR;
    }
    for (;;) {
        const bool has_next = S.next(ui + 1, nxt);
        const char* nA = has_next ? (const char*)(nxt.sel ? g.A2 : g.A) + (size_t)nxt.pm * tstep : cA; const char* nB = has_next ? (const char*)(nxt.sel ? g.Bt2 : g.Bt) + (size_t)nxt.pn * tstep : cB;
        for (int t = 0; t < nt; t += 2) {
            const bool last = (t == nt - 2);
            const char* a1 = cA + (size_t)(t + 1) * kstep;
            const char* a2 = last ? nA : cA + (size_t)(t + 2) * kstep; const char* b2 = last ? nB : cB + (size_t)(t + 2) * kstep;
            const char* a3 = a2 + kstep; const char* b3 = b2 + kstep;
            if (last && has_next) S.a_ready(nxt);
            if constexpr (SP2) {
            PG8_LDB(B0, 0, 0); PG8_LDB(B1, 0, 1); PG8_SCHED; PG8_LDA(At, 0, 0); PG8_STAGE(PG8_SA(1, 1), a1 + hstep, voffA);
            PG8_WAIT_V(8); PG8_WAIT_L(0); PG8_BAR; PG8_MMA(0, 0, At, B0); PG8_MMA(0, 1, At, B1); PG8_BAR; PG8_SCHED;
            PG8_LDA(At, 0, 1); PG8_STAGE(PG8_SB(0, 0), b2, voffB); PG8_STAGE(PG8_SB(0, 1), b2 + hstep, voffB); PG8_STAGE(PG8_SA(0, 0), a2, voffA);
            PG8_WAIT_V(8); PG8_WAIT_L(0); PG8_BAR; PG8_MMA(1, 0, At, B0); PG8_MMA(1, 1, At, B1); PG8_BAR; PG8_SCHED;
            PG8_LDB(B0, 1, 0); PG8_LDB(B1, 1, 1); PG8_SCHED; PG8_LDA(At, 1, 0); PG8_STAGE(PG8_SA(0, 1), a2 + hstep, voffA);
            PG8_WAIT_V(8); PG8_WAIT_L(0); PG8_BAR; PG8_MMA(0, 0, At, B0); PG8_MMA(0, 1, At, B1); PG8_BAR; PG8_SCHED;
            PG8_LDA(At, 1, 1); PG8_STAGE(PG8_SB(1, 0), b3, voffB); PG8_STAGE(PG8_SB(1, 1), b3 + hstep, voffB); PG8_STAGE(PG8_SA(1, 0), a3, voffA);
            PG8_WAIT_V(8); PG8_WAIT_L(0); PG8_BAR; PG8_MMA(1, 0, At, B0); PG8_MMA(1, 1, At, B1); PG8_BAR; PG8_SCHED;
            } else {
            PG8_LDB(B0, 0, 0); PG8_SCHED; PG8_LDA(At, 0, 0); PG8_STAGE(PG8_SA(1, 1), a1 + hstep, voffA);
            PG8_WAIT_L(8); PG8_BAR; PG8_WAIT_L(0); PG8_MMA(0, 0, At, B0); PG8_BAR; PG8_SCHED;
            PG8_LDB(B1, 0, 1); PG8_STAGE(PG8_SB(0, 0), b2, voffB);
            PG8_BAR; PG8_WAIT_L(0); PG8_MMA(0, 1, At, B1); PG8_BAR;
            PG8_LDA(At, 0, 1); PG8_STAGE(PG8_SA(0, 0), a2, voffA);
            PG8_BAR; PG8_WAIT_L(0); PG8_MMA(1, 0, At, B0); PG8_BAR; PG8_SCHED;
            PG8_STAGE(PG8_SB(0, 1), b2 + hstep, voffB);
            PG8_WAIT_V(6); PG8_BAR; PG8_MMA(1, 1, At, B1); PG8_BAR;
            PG8_LDB(B0, 1, 0); PG8_SCHED; PG8_LDA(At, 1, 0); PG8_STAGE(PG8_SA(0, 1), a2 + hstep, voffA);
            PG8_WAIT_L(8); PG8_BAR; PG8_WAIT_L(0); PG8_MMA(0, 0, At, B0); PG8_BAR; PG8_SCHED;
            PG8_LDB(B1, 1, 1); PG8_STAGE(PG8_SB(1, 0), b3, voffB);
            PG8_BAR; PG8_WAIT_L(0); PG8_MMA(0, 1, At, B1); PG8_BAR;
            PG8_LDA(At, 1, 1); PG8_STAGE(PG8_SA(1, 0), a3, voffA);
            PG8_BAR; PG8_WAIT_L(0); PG8_MMA(1, 0, At, B0); PG8_BAR; PG8_SCHED;
            PG8_STAGE(PG8_SB(1, 1), b3 + hstep, voffB);
            PG8_WAIT_V(6); PG8_BAR; PG8_MMA(1, 1, At, B1); PG8_BAR;
            }
        }
        if constexpr (ALIGN_EPI) { if (wr == 0) PG8_BAR; }
        if constexpr (!Epi::AFTER_DRAIN) { E(acc, cur, wr, wc, fr, fq); S.done(cur); }
        if (!has_next) break;
#pragma unroll
        for (int a = 0; a < 2; ++a)
#pragma unroll
            for (int b = 0; b < 2; ++b)
#pragma unroll
                for (int m = 0; m < 4; ++m)
#pragma unroll
                    for (int n = 0; n < 2; ++n) acc[a][b][m][n] = (f32x4){0.f, 0.f, 0.f, 0.f};
        cur = nxt; cA = nA; cB = nB; ++ui;
        if constexpr (ALIGN_EPI) { if (wr == 1) PG8_BAR; }
    }
    PG8_WAIT_V(0);
    if constexpr (!ALIGN_EPI) { if (wr == 0) PG8_BAR; }
    PG8_BAR;
    if constexpr (Epi::AFTER_DRAIN) { E.fused(acc, cur, wr, wc, fr, fq, lds, wid, lane); S.done(cur); }
#undef PG8_SA
#undef PG8_SB
#undef PG8_STAGE
#undef PG8_LDA
#undef PG8_LDB
#undef PG8_MMA
#undef PG8_WAIT_V
#undef PG8_WAIT_L
#undef PG8_BAR
#undef PG8_SCHED
}
typedef float f32x2 __attribute__((ext_vector_type(2)));
typedef unsigned u32x2v __attribute__((ext_vector_type(2)));
typedef __bf16 bf2_t __attribute__((ext_vector_type(2)));
__device__ __forceinline__ unsigned pk_bf16(float a, float b) { f32x2 v = {a, b}; bf2_t r = __builtin_convertvector(v, bf2_t); return __builtin_bit_cast(unsigned, r); }
__device__ __forceinline__ float bf_lo(unsigned w) { return __uint_as_float(w << 16); }
__device__ __forceinline__ float bf_hi(unsigned w) { return __uint_as_float(w & 0xffff0000u); }
__device__ __forceinline__ float sigmoidf_(float x) { return __builtin_amdgcn_rcpf(1.0f + __builtin_amdgcn_exp2f(-1.44269504f * x)); }

struct EpiF32 {
    static constexpr bool PERM = false, AFTER_DRAIN = false;
    float* C; int ldc;
    __device__ __forceinline__ void operator()(const f32x4 (&acc)[2][2][4][2], const Unit& u, int wr, int wc, int fr, int fq) const {
        const int row0 = u.pm * BM + wr * 64 + fr, col0 = u.pn * BM + wc * 32 + 4 * fq;
#pragma unroll
        for (int ai = 0; ai < 2; ++ai)
#pragma unroll
            for (int m = 0; m < 4; ++m) { float* rowp = C + (size_t)(row0 + ai * HALF + m * 16) * ldc + col0;
#pragma unroll
                for (int bj = 0; bj < 2; ++bj)
#pragma unroll
                    for (int n = 0; n < 2; ++n) *(f32x4*)(rowp + bj * HALF + n * 16) = acc[ai][bj][m][n]; }
    }
};
template <bool ACT> struct EpiGlu {
    static constexpr bool PERM = true, AFTER_DRAIN = false;
    bf16_t* O; int ldc;
    __device__ __forceinline__ void operator()(const f32x4 (&acc)[2][2][4][2], const Unit& u, int wr, int wc, int fr, int fq) const {
        const int row0 = u.pm * BM + wr * 64 + fr, col0 = u.pn * HALF + wc * 32 + 8 * fq;
#pragma unroll
        for (int ai = 0; ai < 2; ++ai)
#pragma unroll
            for (int m = 0; m < 4; ++m) { bf16_t* rowp = O + (size_t)(row0 + ai * HALF + m * 16) * ldc + col0;
                float v[8];
#pragma unroll
                for (int n = 0; n < 2; ++n)
#pragma unroll
                    for (int j = 0; j < 4; ++j) { const float g = acc[ai][0][m][n][j], up = acc[ai][1][m][n][j]; v[n * 4 + j] = ACT ? g * sigmoidf_(g) * up : g * up; }
                u32x4 w; w.x = pk_bf16(v[0], v[1]); w.y = pk_bf16(v[2], v[3]); w.z = pk_bf16(v[4], v[5]); w.w = pk_bf16(v[6], v[7]);
                *(u32x4*)rowp = w; }
    }
};
struct EpiBf16 {
    static constexpr bool PERM = true, AFTER_DRAIN = false;
    bf16_t* O; int ldc; int split_tiles; bf16_t* O2; int rope_tiles; const float* cs; const float* sn; int ldc2;
    __device__ __forceinline__ void operator()(const f32x4 (&acc)[2][2][4][2], const Unit& u, int wr, int wc, int fr, int fq) const {
        const int row0 = u.pm * BM + wr * 64 + fr; int pn = u.pn; bf16_t* base = O; int ld = ldc;
        if (split_tiles && pn >= split_tiles) { base = O2; pn -= split_tiles; ld = ldc2; }
        const int col0 = pn * BM + wc * 32 + 8 * fq;
        const bool rope = (u.pn < rope_tiles) && ((wc & 1) == 0);
#pragma unroll
        for (int ai = 0; ai < 2; ++ai)
#pragma unroll
            for (int m = 0; m < 4; ++m) { const int row = row0 + ai * HALF + m * 16; bf16_t* rowp = base + (size_t)row * ld + col0;
                f32x4 c0 = {1.f, 1.f, 1.f, 1.f}, c1 = c0, s0 = {0.f, 0.f, 0.f, 0.f}, s1 = s0;
                if (rope) { const int pos = row & 2047; c0 = *(const f32x4*)(cs + pos * 8); c1 = *(const f32x4*)(cs + pos * 8 + 4); s0 = *(const f32x4*)(sn + pos * 8); s1 = *(const f32x4*)(sn + pos * 8 + 4);
                    if (fq == 0) { s0 = -s0; s1 = -s1; } if (fq >= 2) { c0 = (f32x4){1.f, 1.f, 1.f, 1.f}; c1 = c0; s0 = (f32x4){0.f, 0.f, 0.f, 0.f}; s1 = s0; } }
#pragma unroll
                for (int bj = 0; bj < 2; ++bj) { f32x4 v0 = acc[ai][bj][m][0], v1 = acc[ai][bj][m][1];
                    if (rope) { f32x4 p0, p1;
#pragma unroll
                        for (int j = 0; j < 4; ++j) { p0[j] = __shfl_xor(v0[j], 16); p1[j] = __shfl_xor(v1[j], 16); }
                        v0 = v0 * c0 + p0 * s0; v1 = v1 * c1 + p1 * s1; }
                    u32x4 w; w.x = pk_bf16(v0[0], v0[1]); w.y = pk_bf16(v0[2], v0[3]); w.z = pk_bf16(v1[0], v1[1]); w.w = pk_bf16(v1[2], v1[3]);
                    *(u32x4*)(rowp + bj * HALF) = w; } }
    }
};
template <int PASS> struct EpiGate {
    static constexpr bool PERM = true, AFTER_DRAIN = false;
    const bf16_t* gl; int ldg; const float* bg; bf16_t* m1; bf16_t* mb; int ldc;
    __device__ __forceinline__ void operator()(const f32x4 (&acc)[2][2][4][2], const Unit& u, int wr, int wc, int fr, int fq) const {
        const int row0 = u.pm * BM + wr * 64 + fr, col0 = u.pn * BM + wc * 32 + 8 * fq;
#pragma unroll
        for (int bj = 0; bj < 2; ++bj) { const int col = col0 + bj * HALF;
            const f32x4 b0 = *(const f32x4*)(bg + col), b1 = *(const f32x4*)(bg + col + 4);
#pragma unroll
            for (int ai = 0; ai < 2; ++ai)
#pragma unroll
                for (int m = 0; m < 4; ++m) { const size_t row = (size_t)(row0 + ai * HALF + m * 16);
                    const u32x4 gw = *(const u32x4*)(gl + row * ldg + col);
                    f32x4 g0 = {bf_lo(gw.x), bf_hi(gw.x), bf_lo(gw.y), bf_hi(gw.y)}, g1 = {bf_lo(gw.z), bf_hi(gw.z), bf_lo(gw.w), bf_hi(gw.w)};
                    g0 += b0; g1 += b1; f32x4 v0 = acc[ai][bj][m][0], v1 = acc[ai][bj][m][1];
#pragma unroll
                    for (int j = 0; j < 4; ++j) { v0[j] *= sigmoidf_(g0[j]); v1[j] *= sigmoidf_(g1[j]); }
                    bf16_t* mp = m1 + row * ldc + col;
                    if (PASS == 2) { const u32x4 pw = *(const u32x4*)mp;
                        v0 += (f32x4){bf_lo(pw.x), bf_hi(pw.x), bf_lo(pw.y), bf_hi(pw.y)}; v1 += (f32x4){bf_lo(pw.z), bf_hi(pw.z), bf_lo(pw.w), bf_hi(pw.w)}; }
                    u32x4 w; w.x = pk_bf16(v0[0], v0[1]); w.y = pk_bf16(v0[2], v0[3]); w.z = pk_bf16(v1[0], v1[1]); w.w = pk_bf16(v1[2], v1[3]);
                    *(u32x4*)((PASS == 1 ? mp : mb + row * ldc + col)) = w; } }
    }
};
struct EpiNormRes {
    static constexpr bool PERM = false, AFTER_DRAIN = true;
    const float* xin; float* x; const float* wpost; float scale; const float* wpre; bf16_t* h; float* slots; unsigned* cnt; unsigned ex0;
    template <bool PRE> __device__ __forceinline__ void stats(const f32x4 (&v)[2][2][4][2], const Unit& u, int wr, int wc, int fr, int fq, PG8_LAS unsigned char* lds, int wid, int lane, unsigned ex, f32x4 (&xpre)[4][2][2]) const {
        PG8_LAS float* P = (PG8_LAS float*)lds;
        PG8_LAS float* S = (PG8_LAS float*)(lds + 4096);
#pragma unroll
        for (int ai = 0; ai < 2; ++ai)
#pragma unroll
            for (int m = 0; m < 4; ++m) { float s = 0.f;
#pragma unroll
                for (int bj = 0; bj < 2; ++bj)
#pragma unroll
                    for (int n = 0; n < 2; ++n) { const f32x4 t = v[ai][bj][m][n]; s += (t[0] * t[0] + t[1] * t[1]) + (t[2] * t[2] + t[3] * t[3]); }
                s += __shfl_xor(s, 16); s += __shfl_xor(s, 32);
                if (fq == 0) P[(ai * HALF + wr * 64 + m * 16 + fr) * 4 + wc] = s; }
        asm volatile("s_waitcnt lgkmcnt(0)" ::: "memory"); __builtin_amdgcn_s_barrier(); asm volatile("" ::: "memory");
        const int row = wid * 32 + (lane & 31);
        float* slot = slots + ((size_t)(ex & 1u) * 16384 + (size_t)(u.pm * BM + row)) * 4;
        if (lane < 32) { const float tot = (P[row * 4 + 0] + P[row * 4 + 1]) + (P[row * 4 + 2] + P[row * 4 + 3]);
            __hip_atomic_store(slot + u.pn, tot, __ATOMIC_RELAXED, __HIP_MEMORY_SCOPE_AGENT); }
        asm volatile("s_waitcnt vmcnt(0)" ::: "memory");
        if (lane == 0) __hip_atomic_fetch_add(cnt + 64 * u.pm, 1u, __ATOMIC_RELAXED, __HIP_MEMORY_SCOPE_AGENT);
        if (PRE) {
            const int col0_ = u.pn * BM + wc * 32 + 4 * fq;
#pragma unroll
            for (int m = 0; m < 4; ++m) { const size_t off = (size_t)(u.pm * BM + wr * 64 + m * 16 + fr) * 1024 + col0_;
#pragma unroll
                for (int bj = 0; bj < 2; ++bj)
#pragma unroll
                    for (int n = 0; n < 2; ++n) xpre[m][bj][n] = *(const f32x4*)(xin + off + bj * HALF + n * 16); } }
        if (wid == 0) { const unsigned want = 32u * (ex + 1u); unsigned spins = 0;
            while ((unsigned)__builtin_amdgcn_readfirstlane(__hip_atomic_load(cnt + 64 * u.pm, __ATOMIC_RELAXED, __HIP_MEMORY_SCOPE_AGENT)) < want) { __builtin_amdgcn_s_sleep(2); if (++spins > (1u << 22)) break; }
            __builtin_amdgcn_fence(__ATOMIC_ACQUIRE, "agent"); }
        asm volatile("s_waitcnt vmcnt(0) lgkmcnt(0)" ::: "memory"); __builtin_amdgcn_s_barrier(); asm volatile("" ::: "memory");
        if (lane < 32) { float q = 0.f;
#pragma unroll
            for (int t = 0; t < 4; ++t) q += __hip_atomic_load(slot + t, __ATOMIC_RELAXED, __HIP_MEMORY_SCOPE_AGENT);
            S[row] = __builtin_amdgcn_rsqf(q * (1.0f / 1024.0f) + 1e-6f); }
        asm volatile("s_waitcnt vmcnt(0) lgkmcnt(0)" ::: "memory"); __builtin_amdgcn_s_barrier(); asm volatile("" ::: "memory");
    }
    __device__ __forceinline__ void fused(f32x4 (&acc)[2][2][4][2], const Unit& u, int wr, int wc, int fr, int fq, PG8_LAS unsigned char* lds, int wid, int lane) const {
        const PG8_LAS float* S = (const PG8_LAS float*)(lds + 4096);
        const int col0 = u.pn * BM + wc * 32 + 4 * fq;
        f32x4 xpre[4][2][2];
        stats<true>(acc, u, wr, wc, fr, fq, lds, wid, lane, ex0, xpre);
#pragma unroll
        for (int ai = 0; ai < 2; ++ai)
#pragma unroll
            for (int m = 0; m < 4; ++m) { const int r = ai * HALF + wr * 64 + m * 16 + fr; const float rs = S[r] * scale; const size_t off = (size_t)(u.pm * BM + r) * 1024 + col0;
#pragma unroll
                for (int bj = 0; bj < 2; ++bj)
#pragma unroll
                    for (int n = 0; n < 2; ++n) { const f32x4 xv = (ai == 0) ? xpre[m][bj][n] : *(const f32x4*)(xin + off + bj * HALF + n * 16); const f32x4 w = *(const f32x4*)(wpost + col0 + bj * HALF + n * 16);
                        const f32x4 o = xv + acc[ai][bj][m][n] * rs * w; acc[ai][bj][m][n] = o; *(f32x4*)(x + off + bj * HALF + n * 16) = o; }
                asm volatile("" : "+v"(acc[ai][0][m][0]), "+v"(acc[ai][0][m][1]), "+v"(acc[ai][1][m][0]), "+v"(acc[ai][1][m][1]));
                if (m & 1) asm volatile("" ::: "memory"); }
        if (h == nullptr) return;
        stats<false>(acc, u, wr, wc, fr, fq, lds, wid, lane, ex0 + 1u, xpre);
#pragma unroll
        for (int ai = 0; ai < 2; ++ai)
#pragma unroll
            for (int m = 0; m < 4; ++m) { const int r = ai * HALF + wr * 64 + m * 16 + fr; const float rs = S[r]; const size_t off = (size_t)(u.pm * BM + r) * 1024 + col0;
#pragma unroll
                for (int bj = 0; bj < 2; ++bj)
#pragma unroll
                    for (int n = 0; n < 2; ++n) { const f32x4 w = *(const f32x4*)(wpre + col0 + bj * HALF + n * 16); const f32x4 o = acc[ai][bj][m][n] * rs * w;
                        u32x2v ov; ov.x = pk_bf16(o[0], o[1]); ov.y = pk_bf16(o[2], o[3]); *(u32x2v*)(h + off + bj * HALF + n * 16) = ov; } }
    }
};
template <class E0, class E1> struct EpiSplitN {
    static constexpr bool PERM = E0::PERM, AFTER_DRAIN = false;
    static_assert(E0::PERM == E1::PERM && !E0::AFTER_DRAIN && !E1::AFTER_DRAIN, "composite epilogue parts must agree");
    E0 e0; E1 e1; int split;
    __device__ __forceinline__ void operator()(const f32x4 (&acc)[2][2][4][2], const Unit& u, int wr, int wc, int fr, int fq) const {
        if (u.pn < split) e0(acc, u, wr, wc, fr, fq); else { Unit v = u; v.pn -= split; e1(acc, v, wr, wc, fr, fq); } }
};
template <class E0, class E1> struct EpiSel {
    static constexpr bool PERM = E0::PERM, AFTER_DRAIN = false;
    static_assert(E0::PERM == E1::PERM && !E0::AFTER_DRAIN && !E1::AFTER_DRAIN, "composite epilogue parts must agree");
    E0 e0; E1 e1;
    __device__ __forceinline__ void operator()(const f32x4 (&acc)[2][2][4][2], const Unit& u, int wr, int wc, int fr, int fq) const {
        if (u.sel) e1(acc, u, wr, wc, fr, fq); else e0(acc, u, wr, wc, fr, fq); }
};
}
#define LAS __attribute__((address_space(3)))
typedef unsigned short bf16_t;
typedef short bf16x8 __attribute__((ext_vector_type(8)));
typedef float f32x4 __attribute__((ext_vector_type(4)));
typedef float f32x16 __attribute__((ext_vector_type(16)));
typedef unsigned u32x4 __attribute__((ext_vector_type(4)));
typedef unsigned u32x2 __attribute__((ext_vector_type(2)));
using pg8::pk_bf16; using pg8::bf_lo; using pg8::bf_hi;

constexpr int MTOK = 16384, DM = 1024, SEQ = 2048, DFF = 2816, NTHR = 512;
constexpr int LDS_BYTES = 131072 + 16;
constexpr float EPS = 1e-6f;
constexpr size_t OFF_W13A = 0, OFF_W2A = 11534336, OFF_W13B = 17301504, OFF_W2B = 28835840, OFF_WIN = 34603008, OFF_WCO = 51380224, OFF_WAO = 53477376, OFF_WO = 55574528;
constexpr size_t OFF_HB = 57671680, OFF_TAB = OFF_HB + 33554432, OFF_RB = OFF_TAB + 131072;
constexpr size_t OFF_AB = OFF_RB, OFF_YF1 = OFF_RB + 92274688;
constexpr size_t OFF_TCH = OFF_RB, OFF_BB = OFF_RB + 33554432;
constexpr int QK_LD = 2048 + 128, VT_LD = 16384 + 128;
constexpr size_t OFF_QK = OFF_RB, OFF_VT = OFF_QK + (size_t)MTOK * QK_LD * 2, OFF_GL = OFF_VT + (size_t)1024 * VT_LD * 2, OFF_CB = OFF_GL + 67108864;
constexpr size_t OFF_M1 = OFF_QK, OFF_MB = OFF_VT, OFF_YF2 = OFF_GL, OFF_OB = OFF_HB;
constexpr size_t OFF_BAR = OFF_CB + 33554432;
constexpr size_t OFF_CNT = OFF_BAR + 16384;
constexpr size_t OFF_CEN = OFF_CNT + 16384;
constexpr size_t OFF_SLOT = OFF_CEN + 4096;
constexpr size_t WS_NEED = OFF_SLOT + 524288;

struct Params {
    const float* x; const float* w_in; const float* b_gate; const float* conv_w; const float* w_conv_out; const float* w_attn_out; const float* lam_vec; const float* subln_w;
    const float* w_o; const float* ffn1_w13; const float* ffn1_w2; const float* ffn2_w13; const float* ffn2_w2; const float* norm_w; float* out; unsigned char* ws;
};

typedef const __attribute__((address_space(4))) Params* KPtr_;
__device__ __forceinline__ void convert_weights(KPtr_ kp, int l, int t0, int t1, int bi, int nb) {
    Params p; p.ffn1_w13 = kp->ffn1_w13; p.ffn1_w2 = kp->ffn1_w2; p.ffn2_w13 = kp->ffn2_w13; p.ffn2_w2 = kp->ffn2_w2; p.w_in = kp->w_in; p.w_conv_out = kp->w_conv_out; p.w_attn_out = kp->w_attn_out; p.w_o = kp->w_o; unsigned char* ws = kp->ws;
    const int tid = opaque_tid(), n = tid & 63, kq = tid >> 6;
    for (int t = t0 + bi; t < t1; t += nb) {
        const float* src; bf16_t* dst; int K, ld, mode, tl;
        if (t < 352)       { tl = t;        src = p.ffn1_w13 + (size_t)l * 1024 * 5632; dst = (bf16_t*)(ws + OFF_W13A); K = 1024; ld = 5632; mode = 1; }
        else if (t < 528)  { tl = t - 352;  src = p.ffn1_w2 + (size_t)l * 2816 * 1024;  dst = (bf16_t*)(ws + OFF_W2A);  K = 2816; ld = 1024; mode = 0; }
        else if (t < 880)  { tl = t - 528;  src = p.ffn2_w13 + (size_t)l * 1024 * 5632; dst = (bf16_t*)(ws + OFF_W13B); K = 1024; ld = 5632; mode = 1; }
        else if (t < 1056) { tl = t - 880;  src = p.ffn2_w2 + (size_t)l * 2816 * 1024;  dst = (bf16_t*)(ws + OFF_W2B);  K = 2816; ld = 1024; mode = 0; }
        else if (t < 1568) { tl = t - 1056; src = p.w_in + (size_t)l * 1024 * 8192;     dst = (bf16_t*)(ws + OFF_WIN);  K = 1024; ld = 8192; mode = 2; }
        else if (t < 1632) { tl = t - 1568; src = p.w_conv_out + (size_t)l * 1048576;   dst = (bf16_t*)(ws + OFF_WCO);  K = 1024; ld = 1024; mode = 0; }
        else if (t < 1696) { tl = t - 1632; src = p.w_attn_out + (size_t)l * 1048576;   dst = (bf16_t*)(ws + OFF_WAO);  K = 1024; ld = 1024; mode = 0; }
        else               { tl = t - 1696; src = p.w_o + (size_t)l * 1048576;          dst = (bf16_t*)(ws + OFF_WO);   K = 1024; ld = 1024; mode = 0; }
        const int KT = K / 256, nb = tl / KT, kb = tl % KT, n0 = nb * 64; int src0 = n0;
        if (mode == 1) { const int pn = n0 >> 8, bj = (n0 >> 7) & 1, jj = n0 & 127; src0 = bj * DFF + pn * 128 + jj; }
        if (mode == 2) {
            if (n0 < 2048) { const int pn = n0 >> 8, bj = (n0 >> 7) & 1, jj = n0 & 127; src0 = 1024 + bj * 1024 + pn * 128 + jj; }
            else if (n0 < 3072) src0 = n0 - 2048;
            else src0 = (n0 < 5120) ? n0 : (n0 < 7168 ? n0 + 1024 : n0 - 2048); }
        const int k0 = kb * 256 + kq * 32;
        const float* sp = src + (size_t)k0 * ld + src0 + n;
        float v[32];
#pragma unroll
        for (int j = 0; j < 32; ++j) v[j] = sp[(size_t)j * ld];
        bf16_t* dp = dst + (size_t)(n0 + n) * K + k0;
#pragma unroll
        for (int q = 0; q < 4; ++q) { u32x4 w; w.x = pk_bf16(v[8 * q], v[8 * q + 1]); w.y = pk_bf16(v[8 * q + 2], v[8 * q + 3]); w.z = pk_bf16(v[8 * q + 4], v[8 * q + 5]); w.w = pk_bf16(v[8 * q + 6], v[8 * q + 7]);
            *(u32x4*)(dp + 8 * q) = w; }
    }
}
__device__ __forceinline__ void rope_tables(float* cs, float* sn) {
    for (int i = blockIdx.x * NTHR + opaque_tid(); i < SEQ * 8; i += gridDim.x * NTHR) {
        const int pos = i >> 3, j = i & 7;
        const float inv = (float)pow(500000.0, -(double)j / 8.0);
        const float ang = (float)pos * inv;
        cs[i] = (float)cos((double)ang); sn[i] = (float)sin((double)ang);
    }
}

__device__ __forceinline__ float sum16(float v) { v += __shfl_xor(v, 8); v += __shfl_xor(v, 4); v += __shfl_xor(v, 2); v += __shfl_xor(v, 1); return v; }
template <int MODE> __device__ __forceinline__ void row_phase(const float* xin, float* x, const bf16_t* y, const float* wpost, float scale, const float* wpre, bf16_t* h) {
    const int tid = opaque_tid(), lane = tid & 63, wid = tid >> 6, sub = lane >> 4, l16 = lane & 15;
    for (int row = (blockIdx.x * 8 + wid) * 4 + sub; row < MTOK; row += gridDim.x * 32) {
        const size_t ro = (size_t)row * DM + l16 * 4;
        f32x4 xv[16];
        if (MODE == 0 || MODE == 3) {
#pragma unroll
            for (int i = 0; i < 16; ++i) xv[i] = *(const f32x4*)(xin + ro + i * 64);
        } else {
            f32x4 yv[16]; float ss = 0.f;
#pragma unroll
            for (int i = 0; i < 16; ++i) { const u32x2 yw = *(const u32x2*)(y + ro + i * 64); yv[i] = (f32x4){bf_lo(yw.x), bf_hi(yw.x), bf_lo(yw.y), bf_hi(yw.y)}; xv[i] = *(const f32x4*)(x + ro + i * 64); }
#pragma unroll
            for (int i = 0; i < 16; ++i) ss += yv[i][0] * yv[i][0] + yv[i][1] * yv[i][1] + yv[i][2] * yv[i][2] + yv[i][3] * yv[i][3];
            ss = sum16(ss); const float rs = scale * __builtin_amdgcn_rsqf(ss * (1.0f / DM) + EPS);
#pragma unroll
            for (int i = 0; i < 16; ++i) { const f32x4 w = *(const f32x4*)(wpost + l16 * 4 + i * 64); xv[i] += yv[i] * rs * w; }
        }
        if (MODE != 3) {
#pragma unroll
            for (int i = 0; i < 16; ++i) *(f32x4*)(x + ro + i * 64) = xv[i]; }
        if (MODE != 2) {
            float ss = 0.f;
#pragma unroll
            for (int i = 0; i < 16; ++i) ss += xv[i][0] * xv[i][0] + xv[i][1] * xv[i][1] + xv[i][2] * xv[i][2] + xv[i][3] * xv[i][3];
            ss = sum16(ss); const float rs = __builtin_amdgcn_rsqf(ss * (1.0f / DM) + EPS);
#pragma unroll
            for (int i = 0; i < 16; ++i) { const f32x4 w = *(const f32x4*)(wpre + l16 * 4 + i * 64); const f32x4 v = xv[i] * rs * w;
                u32x2 o; o.x = pk_bf16(v[0], v[1]); o.y = pk_bf16(v[2], v[3]); *(u32x2*)(h + ro + i * 64) = o; }
        }
    }
}

__device__ __forceinline__ void ld8(const bf16_t* p, float (&v)[8]) { const u32x4 w = *(const u32x4*)p; v[0] = bf_lo(w.x); v[1] = bf_hi(w.x); v[2] = bf_lo(w.y); v[3] = bf_hi(w.y); v[4] = bf_lo(w.z); v[5] = bf_hi(w.z); v[6] = bf_lo(w.w); v[7] = bf_hi(w.w); }
__device__ __forceinline__ void conv_phase(const bf16_t* tb, const bf16_t* bb, const float* cw, bf16_t* cb) {
    for (int item = blockIdx.x * NTHR + opaque_tid(); item < 262144; item += gridDim.x * NTHR) {
        const int cgp = item & 127, chunk = item >> 7, c0 = cgp * 8, tok0 = chunk * 8, s0 = tok0 & (SEQ - 1);
        u32x4 tr[10], br[8];
        const u32x4 z4 = {0u, 0u, 0u, 0u};
#pragma unroll
        for (int i = 0; i < 10; ++i) { const int s = s0 - 1 + i; const bool ok = (s >= 0) && (s < SEQ); tr[i] = ok ? *(const u32x4*)(tb + (size_t)(tok0 - 1 + i) * DM + c0) : z4; }
#pragma unroll
        for (int i = 0; i < 8; ++i) br[i] = *(const u32x4*)(bb + (size_t)(tok0 + i) * DM + c0);
        float w0[8], w1[8], w2[8];
#pragma unroll
        for (int j = 0; j < 8; ++j) { w0[j] = cw[c0 + j]; w1[j] = cw[1024 + c0 + j]; w2[j] = cw[2048 + c0 + j]; }
        float tp[8], tc[8], tn[8];
#define CONV_T(dst, i) do { const u32x4 a_ = tr[i]; dst[0] = bf_lo(a_.x); dst[1] = bf_hi(a_.x); dst[2] = bf_lo(a_.y); dst[3] = bf_hi(a_.y); dst[4] = bf_lo(a_.z); dst[5] = bf_hi(a_.z); dst[6] = bf_lo(a_.w); dst[7] = bf_hi(a_.w); } while (0)
        CONV_T(tp, 0); CONV_T(tc, 1);
#pragma unroll
        for (int i = 0; i < 8; ++i) {
            CONV_T(tn, i + 2);
            const u32x4 bw = br[i]; const float bv[8] = {bf_lo(bw.x), bf_hi(bw.x), bf_lo(bw.y), bf_hi(bw.y), bf_lo(bw.z), bf_hi(bw.z), bf_lo(bw.w), bf_hi(bw.w)};
            float o[8];
#pragma unroll
            for (int j = 0; j < 8; ++j) { o[j] = bv[j] * (w0[j] * tp[j] + w1[j] * tc[j] + w2[j] * tn[j]); tp[j] = tc[j]; tc[j] = tn[j]; }
            u32x4 w; w.x = pk_bf16(o[0], o[1]); w.y = pk_bf16(o[2], o[3]); w.z = pk_bf16(o[4], o[5]); w.w = pk_bf16(o[6], o[7]);
            *(u32x4*)(cb + (size_t)(tok0 + i) * DM + c0) = w;
        }
#undef CONV_T
    }
}

#ifndef ATT_SCHED
#define ATT_SCHED 0
#endif
__device__ __forceinline__ float fmax3(float a, float b, float c) { return fmaxf(fmaxf(a, b), c); }
__device__ __forceinline__ void attn_phase(LAS unsigned char* lds, const bf16_t* qk, const bf16_t* vt, bf16_t* ob, const float* lv, const float* subln, float lam_init, int vcb) {
    const int tid = opaque_tid(), wid = __builtin_amdgcn_readfirstlane(tid >> 6), lane = tid & 63, r = lane & 31, hf = lane >> 5;
    const int c = wid >> 2, qw = wid & 3;
    float d1 = 0.f, d2 = 0.f;
    for (int i = 0; i < 64; ++i) { d1 += lv[i] * lv[64 + i]; d2 += lv[128 + i] * lv[192 + i]; }
    const float lam = expf(d1) - expf(d2) + lam_init;
    const float C2 = 0.125f * 1.44269504f;
    const int G = gridDim.x, cb = vcb;
    const int pr = (r & ~12) | ((r & 4) << 1) | ((r & 8) >> 1);
    const int ksw = (pr >> 1) & 7, vsw = (r >> 1) & 7;
    const int srow = tid >> 3, sch = tid & 7;
    for (int it = 0;; ++it) {
        const int u = it * G + cb; if (u >= 1024) break;
        int bh, qb;
        if (G == 256) { bh = it * 16 + (cb & 7) * 2 + (cb >> 7); qb = (cb >> 3) & 15; } else { bh = u >> 4; qb = u & 15; }
        const int b = bh >> 3, h = bh & 7;
        const size_t tok0 = (size_t)b * SEQ;
        const size_t qtok = tok0 + qb * 128 + qw * 32 + r;
        const bf16_t* qrow = qk + qtok * QK_LD + h * 128 + c * 64 + 8 * hf;
        bf16x8 Qf[4];
#pragma unroll
        for (int kk = 0; kk < 4; ++kk) Qf[kk] = *(const bf16x8*)(qrow + 16 * kk);
        f32x16 O[4];
#pragma unroll
        for (int d = 0; d < 4; ++d)
#pragma unroll
            for (int i = 0; i < 16; ++i) O[d][i] = 0.f;
        float mrun = -1e30f, lrun = 0.f;
        const int gch = sch ^ ((srow >> 1) & 7);
        const bf16_t* kg = qk + (tok0 + srow) * QK_LD + 1024 + h * 128 + gch * 8;
        const bf16_t* vg = vt + (size_t)(h * 128 + srow) * VT_LD + tok0 + gch * 8;
#define ATT_ISSUE(t) do { const int tt_ = ((t) + 2 * qb) & 31; LAS unsigned char* bs = lds + ((t) & 3) * 32768 + wid * 1024; \
            __builtin_amdgcn_global_load_lds((const unsigned*)(kg + (size_t)tt_ * 64 * QK_LD), (LAS unsigned*)(bs), 16, 0, 0); \
            __builtin_amdgcn_global_load_lds((const unsigned*)(kg + (size_t)tt_ * 64 * QK_LD + 64), (LAS unsigned*)(bs + 8192), 16, 0, 0); \
            __builtin_amdgcn_global_load_lds((const unsigned*)(vg + tt_ * 64), (LAS unsigned*)(bs + 16384), 16, 0, 0); \
            __builtin_amdgcn_global_load_lds((const unsigned*)(vg + tt_ * 64 + (size_t)64 * VT_LD), (LAS unsigned*)(bs + 24576), 16, 0, 0); } while (0)
#define ATT_KLD(buf) do { const LAS unsigned char* kb_ = lds + (buf) * 32768 + c * 8192 + pr * 128; \
            _Pragma("unroll") for (int kk = 0; kk < 4; ++kk) { const int off = ((2 * kk + hf) ^ ksw) << 4; Kf[kk] = *(const LAS bf16x8*)(kb_ + off); Kf[4 + kk] = *(const LAS bf16x8*)(kb_ + 32 * 128 + off); } } while (0)
#define ATT_QKM(D0, D1) do { _Pragma("unroll") for (int i = 0; i < 16; ++i) { D0[i] = 0.f; D1[i] = 0.f; } \
            _Pragma("unroll") for (int kk = 0; kk < 4; ++kk) { D0 = __builtin_amdgcn_mfma_f32_32x32x16_bf16(Kf[kk], Qf[kk], D0, 0, 0, 0); D1 = __builtin_amdgcn_mfma_f32_32x32x16_bf16(Kf[4 + kk], Qf[kk], D1, 0, 0, 0); } } while (0)
#define ATT_VLD(DST, buf, d0) do { const LAS unsigned char* vb_ = lds + (buf) * 32768 + 16384 + r * 128; \
            _Pragma("unroll") for (int dd = 0; dd < 2; ++dd) _Pragma("unroll") for (int kb = 0; kb < 2; ++kb) _Pragma("unroll") for (int s = 0; s < 2; ++s) \
                DST[dd * 4 + kb * 2 + s] = *(const LAS bf16x8*)(vb_ + ((d0) + dd) * 32 * 128 + (((4 * kb + 2 * s + hf) ^ vsw) << 4)); } while (0)
#define ATT_PVM(SRC, d0) do { _Pragma("unroll") for (int kb = 0; kb < 2; ++kb) _Pragma("unroll") for (int s = 0; s < 2; ++s) _Pragma("unroll") for (int dd = 0; dd < 2; ++dd) \
                O[(d0) + dd] = __builtin_amdgcn_mfma_f32_32x32x16_bf16(SRC[dd * 4 + kb * 2 + s], P[kb][s], O[(d0) + dd], 0, 0, 0); } while (0)
#define ATT_BAR() do { asm volatile("" ::: "memory"); __builtin_amdgcn_s_barrier(); asm volatile("" ::: "memory"); } while (0)
#define ATT_SB() __builtin_amdgcn_sched_barrier(0)
        ATT_ISSUE(0); ATT_ISSUE(1); if (c == 0) ATT_ISSUE(2);
        asm volatile("s_waitcnt vmcnt(0)" ::: "memory"); ATT_BAR();
        f32x16 S0, S1;
        bf16x8 Kf[8], VA[8];
        bf16x8 P[2][2];
        ATT_KLD(0); ATT_QKM(S0, S1);
#define ATT_PV(buf) do { ATT_VLD(VA, (buf), 0); ATT_SB(); ATT_PVM(VA, 0); ATT_SB(); ATT_VLD(VA, (buf), 2); ATT_SB(); ATT_PVM(VA, 2); ATT_SB(); } while (0)
        for (int t = 0; t < 32; ++t) {
            if (c == 1 && t < 30) ATT_ISSUE(t + 2);
            if (t > 0) ATT_PV((t - 1) & 3);
            if (c == 0) { asm volatile("s_waitcnt vmcnt(0)" ::: "memory"); ATT_BAR(); if (t < 29) ATT_ISSUE(t + 3); }
            ATT_KLD((t + 1) & 3);
            ATT_SB();
            float tm = fmaxf(S0[0], S1[0]);
#pragma unroll
            for (int i = 1; i < 16; ++i) tm = fmax3(tm, S0[i], S1[i]);
            tm = fmaxf(tm, __shfl_xor(tm, 32));
            const bool upd = tm > mrun + 64.0f;
            const float mn = upd ? tm : mrun, alpha = __builtin_amdgcn_exp2f((mrun - mn) * C2), mc = mn * C2;
            mrun = mn;
            if (__builtin_amdgcn_ballot_w64(upd) != 0ull) {
#pragma unroll
                for (int d = 0; d < 4; ++d)
#pragma unroll
                    for (int i = 0; i < 16; ++i) O[d][i] *= alpha;
            }
            ATT_SB();
            f32x16 N0, N1;
            ATT_QKM(N0, N1);
            float rs = 0.f;
#pragma unroll
            for (int i = 0; i < 16; ++i) { S0[i] = __builtin_amdgcn_exp2f(S0[i] * C2 - mc); S1[i] = __builtin_amdgcn_exp2f(S1[i] * C2 - mc); rs += S0[i] + S1[i]; }
            lrun = lrun * alpha + rs;
#pragma unroll
            for (int s = 0; s < 2; ++s) {
                u32x4 w0, w1;
                w0.x = pk_bf16(S0[8 * s + 0], S0[8 * s + 1]); w0.y = pk_bf16(S0[8 * s + 2], S0[8 * s + 3]); w0.z = pk_bf16(S0[8 * s + 4], S0[8 * s + 5]); w0.w = pk_bf16(S0[8 * s + 6], S0[8 * s + 7]);
                w1.x = pk_bf16(S1[8 * s + 0], S1[8 * s + 1]); w1.y = pk_bf16(S1[8 * s + 2], S1[8 * s + 3]); w1.z = pk_bf16(S1[8 * s + 4], S1[8 * s + 5]); w1.w = pk_bf16(S1[8 * s + 6], S1[8 * s + 7]);
                P[0][s] = __builtin_bit_cast(bf16x8, w0); P[1][s] = __builtin_bit_cast(bf16x8, w1);
            }
            ATT_SB();
            if (c == 1) { asm volatile("s_waitcnt vmcnt(0)" ::: "memory"); ATT_BAR(); }
            S0 = N0; S1 = N1;
        }
        ATT_PV(31 & 3);
#undef ATT_PV
#undef ATT_KLD
#undef ATT_QKM
#undef ATT_VLD
#undef ATT_PVM
#undef ATT_ISSUE
        const float lt = lrun + __shfl_xor(lrun, 32);
        LAS float* X = (LAS float*)lds + qw * 4096 + lane;
        if (c == 1) { const float sc = lam / lt;
#pragma unroll
            for (int d = 0; d < 4; ++d)
#pragma unroll
                for (int i = 0; i < 16; ++i) X[(d * 16 + i) * 64] = O[d][i] * sc; }
        __syncthreads();
        if (c == 0) { const float sc = 1.0f / lt; float ss = 0.f;
#pragma unroll
            for (int d = 0; d < 4; ++d)
#pragma unroll
                for (int i = 0; i < 16; ++i) { const float o = O[d][i] * sc - X[(d * 16 + i) * 64]; O[d][i] = o; ss += o * o; }
            ss += __shfl_xor(ss, 32);
            const float rms = __builtin_amdgcn_rsqf(ss * (1.0f / 128.0f) + EPS) * (1.0f - lam_init);
            bf16_t* orow = ob + qtok * DM + h * 128 + 4 * hf;
#pragma unroll
            for (int d = 0; d < 4; ++d)
#pragma unroll
                for (int g = 0; g < 4; ++g) { const int dv = 32 * d + 8 * g;
                    const f32x4 w = *(const f32x4*)(subln + dv + 4 * hf);
                    u32x2 o; o.x = pk_bf16(O[d][4 * g] * rms * w[0], O[d][4 * g + 1] * rms * w[1]); o.y = pk_bf16(O[d][4 * g + 2] * rms * w[2], O[d][4 * g + 3] * rms * w[3]);
                    *(u32x2*)(orow + dv) = o; } }
        __syncthreads();
    }
}
#define XB_TMO      128
#define XB_XCNT(j)  (256  + 64 * (j))
#define XB_XSUB(j)  (1280 + 64 * (j))
#define XB_XGEN(j)  (2304 + 64 * (j))
#define XB_TOP      3328
#define XB_TOPGEN   3392
#define XCD_BAR_WORDS 3456
#define XB_SPIN_CAP (1u << 18)

__device__ __forceinline__ unsigned xb_ld(unsigned* p)              { return __hip_atomic_load(p, __ATOMIC_RELAXED, __HIP_MEMORY_SCOPE_AGENT); }
__device__ __forceinline__ unsigned xb_add(unsigned* p, unsigned v) { return __hip_atomic_fetch_add(p, v, __ATOMIC_RELAXED, __HIP_MEMORY_SCOPE_AGENT); }
__device__ __forceinline__ unsigned xb_xcc_id() { return (unsigned)__builtin_amdgcn_s_getreg((3 << 11) | 20) & 0xFu; }
#define XB_SPIN(cond, bar) do { unsigned _sp = 0; while (cond) { __builtin_amdgcn_s_sleep(1); \
    if ((++_sp & 255u) == 0u) { if (xb_ld(&(bar)[XB_TMO])) break; if (_sp > XB_SPIN_CAP) { atomicAdd(&(bar)[XB_TMO], 1u); break; } } } } while (0)

struct XcdBarrier {
    unsigned* bar; unsigned x;
    volatile LAS unsigned* st;
};

__device__ __forceinline__ XcdBarrier xcd_barrier_post(unsigned* bar, volatile LAS unsigned* st) {
    XcdBarrier b; b.bar = bar; b.x = xb_xcc_id(); b.st = st;
    if (threadIdx.x == 0) (void)xb_add(&bar[XB_XCNT(b.x)], 1u);
    return b;
}
__device__ __forceinline__ void xcd_barrier_complete(unsigned* bar, unsigned x, unsigned& nloc, unsigned& nx) {
    const unsigned G = gridDim.x * gridDim.y * gridDim.z;
    unsigned sum, cnt, mine, sp = 0u;
    for (;;) {
        sum = 0u; cnt = 0u; mine = 0u;
#pragma unroll
        for (unsigned j = 0; j < 16; ++j) { const unsigned c = xb_ld(&bar[XB_XCNT(j)]); sum += c; cnt += (c > 0u) ? 1u : 0u; mine = (j == x) ? c : mine; }
        if (sum == G) break;
        __builtin_amdgcn_s_sleep(1);
        if ((++sp & 255u) == 0u) { if (xb_ld(&bar[XB_TMO])) break; if (sp > XB_SPIN_CAP) { atomicAdd(&bar[XB_TMO], 1u); break; } }
    }
    nloc = mine > 0u ? mine : 1u; nx = cnt > 0u ? cnt : 1u;
}

__device__ __forceinline__ void xcd_barrier(const XcdBarrier& b) {
    asm volatile("s_waitcnt vmcnt(0)" ::: "memory");
    __syncthreads();
    if (threadIdx.x == 0) {
        unsigned* bar = b.bar;
        __builtin_amdgcn_s_waitcnt(0);
        unsigned nloc = b.st[0], nx = b.st[1];
        if (nloc == 0u) { xcd_barrier_complete(bar, b.x, nloc, nx); b.st[0] = nloc; b.st[1] = nx; }
        const unsigned old = xb_add(&bar[XB_XSUB(b.x)], 1u);
        const unsigned gen = old / nloc;
        if (old + 1u == (gen + 1u) * nloc) {
            __builtin_amdgcn_fence(__ATOMIC_RELEASE, "agent");
            asm volatile("s_waitcnt vmcnt(0)" ::: "memory");
            const unsigned og = xb_add(&bar[XB_TOP], 1u);
            const unsigned tg = og / nx;
            if (og + 1u == (tg + 1u) * nx) xb_add(&bar[XB_TOPGEN], 1u);
            else XB_SPIN(xb_ld(&bar[XB_TOPGEN]) == tg, bar);
            __builtin_amdgcn_fence(__ATOMIC_ACQUIRE, "agent");
            xb_add(&bar[XB_XGEN(b.x)], 1u);
            asm volatile("s_waitcnt vmcnt(0)" ::: "memory");
        } else {
            XB_SPIN(xb_ld(&bar[XB_XGEN(b.x)]) == gen, bar);
            __builtin_amdgcn_fence(__ATOMIC_ACQUIRE, "agent");
            asm volatile("s_waitcnt vmcnt(0)" ::: "memory");
        }
    }
    __syncthreads();
}
#ifndef REP_GEMM
#define REP_GEMM 1
#endif
#ifndef REP_ATTN
#define REP_ATTN 1
#endif
#ifndef REP_CONV
#define REP_CONV 1
#endif
#ifndef REP_CVT
#define REP_CVT 1
#endif
#ifndef REP_SYNC
#define REP_SYNC 1
#endif
#define GSYNC() do { for (int rep_ = 0; rep_ < REP_SYNC; ++rep_) xcd_barrier(bar); } while (0)
template <class Epi> __device__ __forceinline__ void run_gemm2_(LAS unsigned char* lds, const bf16_t* A0, const bf16_t* B0, int M0, int N0, const bf16_t* A1, const bf16_t* B1, int M1, int N1, int K, const Epi& E, int vcb) {
    pg8::Gemm g{A0, B0, M0, N0, K, A1, B1}; pg8::DualOrder S; S.init(M0, N0, M1, N1, (int)gridDim.x, vcb);
    for (int rep = 0; rep < REP_GEMM; ++rep) pg8::gemm_phase<Epi, pg8::DualOrder, true, true>(lds, g, S, E);
}
template <class Epi> __device__ __forceinline__ void run_gemm_(LAS unsigned char* lds, const bf16_t* A, const bf16_t* Bt, int M, int N, int K, const Epi& E, int vcb) {
    pg8::Gemm g{A, Bt, M, N, K, nullptr, nullptr}; pg8::StaticOrder S; S.init(M, N, (int)gridDim.x, vcb);
    for (int rep = 0; rep < REP_GEMM; ++rep) pg8::gemm_phase<Epi, pg8::StaticOrder, !Epi::AFTER_DRAIN, true>(lds, g, S, E);
}

typedef const __attribute__((address_space(4))) Params* KPtr;
__device__ __forceinline__ KPtr kparams() { KPtr kp = (KPtr)__builtin_amdgcn_kernarg_segment_ptr(); asm volatile("" : "+s"(kp)); return kp; }
#define WSP(T, off) ((T*)(kparams()->ws + (off)))
__device__ __forceinline__ int vcb_read(LAS unsigned char* lds) { unsigned off = 131072u + 8u; asm volatile("" : "+v"(off)); return (int)__builtin_amdgcn_readfirstlane(*(volatile LAS unsigned*)(lds + off)); }
#define VCB() vcb_read(lds)
#define run_gemm(...) run_gemm_(__VA_ARGS__, VCB())
#define run_gemm2(...) run_gemm2_(__VA_ARGS__, VCB())
template <bool fusedn> __global__ void __launch_bounds__(NTHR) fwd_megakernel(Params p_unused) {
    extern __shared__ __attribute__((aligned(16))) unsigned char smem[];
    cg::grid_group grid = cg::this_grid();
    LAS unsigned char* lds = (LAS unsigned char*)smem;
    if (threadIdx.x < 4) ((LAS unsigned*)(lds + 131072))[threadIdx.x] = 0u;
    __syncthreads();
    const XcdBarrier bar = xcd_barrier_post(WSP(unsigned, OFF_BAR), (volatile LAS unsigned*)(lds + 131072));
    if (threadIdx.x == 0) { unsigned* cen = WSP(unsigned, OFF_CEN); ((volatile LAS unsigned*)(lds + 131072))[3] = __hip_atomic_fetch_add(cen + 64 * bar.x, 1u, __ATOMIC_RELAXED, __HIP_MEMORY_SCOPE_AGENT); }

    { const KPtr kp = kparams(); for (int rep = 0; rep < REP_CVT; ++rep) convert_weights(kp, 0, 0, 528, (int)blockIdx.x, (int)gridDim.x); }
    rope_tables(WSP(float, OFF_TAB), WSP(float, OFF_TAB) + SEQ * 8);
    { const KPtr kp = kparams(); if constexpr (fusedn) row_phase<3>(kp->x, nullptr, nullptr, nullptr, 0.f, kp->norm_w, WSP(bf16_t, OFF_HB)); else row_phase<0>(kp->x, kp->out, nullptr, nullptr, 0.f, kp->norm_w, WSP(bf16_t, OFF_HB)); }
    grid.sync();
    if (threadIdx.x == 0) { unsigned* cen = WSP(unsigned, OFF_CEN); const unsigned per = gridDim.x >> 3; bool ok = (gridDim.x & 7u) == 0u && bar.x < 8u;
        for (int j = 0; j < 8; ++j) ok = ok && (__hip_atomic_load(cen + 64 * j, __ATOMIC_RELAXED, __HIP_MEMORY_SCOPE_AGENT) == per);
        volatile LAS unsigned* w = (volatile LAS unsigned*)(lds + 131072); w[2] = ok ? (w[3] * 8u + bar.x) : blockIdx.x; }
    __syncthreads();
    for (int l = 0; l < 2; ++l) {
        run_gemm(lds, WSP(bf16_t, OFF_HB), WSP(bf16_t, OFF_W13A), MTOK, 2 * DFF, DM, pg8::EpiGlu<true>{WSP(bf16_t, OFF_AB), DFF});
        { const int rem = 1408 % (int)gridDim.x, vc = VCB(); const KPtr kp = kparams();
          if (rem == 0) convert_weights(kp, l, 528, 1760, vc, (int)gridDim.x); else if (vc >= rem) convert_weights(kp, l, 528, 1760, vc - rem, (int)gridDim.x - rem); }
        GSYNC();
        if constexpr (fusedn) { const KPtr kp = kparams(); const float* nw = kp->norm_w + (size_t)l * 6 * DM;
            run_gemm(lds, WSP(bf16_t, OFF_AB), WSP(bf16_t, OFF_W2A), MTOK, DM, DFF, pg8::EpiNormRes{l == 0 ? kp->x : kp->out, kp->out, nw + DM, 0.5f, nw + 2 * DM, WSP(bf16_t, OFF_HB), WSP(float, OFF_SLOT), WSP(unsigned, OFF_CNT), (unsigned)(l * 6)}); }
        else { run_gemm(lds, WSP(bf16_t, OFF_AB), WSP(bf16_t, OFF_W2A), MTOK, DM, DFF, pg8::EpiBf16{WSP(bf16_t, OFF_YF1), DM, 0, nullptr, 0, nullptr, nullptr, 0}); GSYNC();
            const KPtr kp = kparams(); const float* nw = kp->norm_w + (size_t)l * 6 * DM; row_phase<1>(nullptr, kp->out, WSP(bf16_t, OFF_YF1), nw + DM, 0.5f, nw + 2 * DM, WSP(bf16_t, OFF_HB)); }
        GSYNC();
        { typedef pg8::EpiSplitN<pg8::EpiGlu<false>, pg8::EpiBf16> EpiTB;
          run_gemm(lds, WSP(bf16_t, OFF_HB), WSP(bf16_t, OFF_WIN), MTOK, 3072, DM, EpiTB{pg8::EpiGlu<false>{WSP(bf16_t, OFF_TCH), DM}, pg8::EpiBf16{WSP(bf16_t, OFF_BB), DM, 0, nullptr, 0, nullptr, nullptr, 0}, 8}); }
        GSYNC();
        for (int rep = 0; rep < REP_CONV; ++rep) conv_phase(WSP(bf16_t, OFF_TCH), WSP(bf16_t, OFF_BB), kparams()->conv_w + (size_t)l * 3 * DM, WSP(bf16_t, OFF_CB));
        GSYNC();
        { typedef pg8::EpiSel<pg8::EpiBf16, pg8::EpiBf16> EpiQV;
          run_gemm2(lds, WSP(bf16_t, OFF_HB), WSP(bf16_t, OFF_WIN) + (size_t)3072 * DM, MTOK, 4096, WSP(bf16_t, OFF_WIN) + (size_t)7168 * DM, WSP(bf16_t, OFF_HB), DM, MTOK, DM,
                    EpiQV{pg8::EpiBf16{WSP(bf16_t, OFF_QK), QK_LD, 8, WSP(bf16_t, OFF_GL), 8, WSP(float, OFF_TAB), WSP(float, OFF_TAB) + SEQ * 8, 2048},
                          pg8::EpiBf16{WSP(bf16_t, OFF_VT), VT_LD, 0, nullptr, 0, nullptr, nullptr, 0}}); }
        GSYNC();
        { const KPtr kp = kparams(); const float lam_init = 0.8f - 0.6f * expf(-0.3f * (float)l);
          for (int rep = 0; rep < REP_ATTN; ++rep) attn_phase(lds, WSP(bf16_t, OFF_QK), WSP(bf16_t, OFF_VT), WSP(bf16_t, OFF_OB), kp->lam_vec + (size_t)l * 256, kp->subln_w + (size_t)l * 128, lam_init, VCB()); }
        GSYNC();
        { const KPtr kp = kparams(); const float* bgp = kp->b_gate + (size_t)l * 2048;
          const pg8::EpiGate<1> e1{WSP(bf16_t, OFF_GL), 2048, bgp, WSP(bf16_t, OFF_M1), WSP(bf16_t, OFF_MB), DM};
          const pg8::EpiGate<2> e2{WSP(bf16_t, OFF_GL) + 1024, 2048, bgp + 1024, WSP(bf16_t, OFF_M1), WSP(bf16_t, OFF_MB), DM};
          if constexpr (fusedn) { typedef pg8::EpiSel<pg8::EpiGate<1>, pg8::EpiGate<2>> EpiG;
              run_gemm2(lds, WSP(bf16_t, OFF_CB), WSP(bf16_t, OFF_WCO), MTOK, DM, WSP(bf16_t, OFF_OB), WSP(bf16_t, OFF_WAO), MTOK, DM, DM, EpiG{e1, e2}); }
          else { run_gemm(lds, WSP(bf16_t, OFF_CB), WSP(bf16_t, OFF_WCO), MTOK, DM, DM, e1); run_gemm(lds, WSP(bf16_t, OFF_OB), WSP(bf16_t, OFF_WAO), MTOK, DM, DM, e2); } }
        GSYNC();
        if constexpr (fusedn) { const KPtr kp = kparams(); const float* nw = kp->norm_w + (size_t)l * 6 * DM;
            run_gemm(lds, WSP(bf16_t, OFF_MB), WSP(bf16_t, OFF_WO), MTOK, DM, DM, pg8::EpiNormRes{kp->out, kp->out, nw + 3 * DM, 1.0f, nw + 4 * DM, WSP(bf16_t, OFF_HB), WSP(float, OFF_SLOT), WSP(unsigned, OFF_CNT), (unsigned)(l * 6 + 2)}); }
        else { run_gemm(lds, WSP(bf16_t, OFF_MB), WSP(bf16_t, OFF_WO), MTOK, DM, DM, pg8::EpiBf16{WSP(bf16_t, OFF_YF2), DM, 0, nullptr, 0, nullptr, nullptr, 0}); GSYNC();
            const KPtr kp = kparams(); const float* nw = kp->norm_w + (size_t)l * 6 * DM; row_phase<1>(nullptr, kp->out, WSP(bf16_t, OFF_YF2), nw + 3 * DM, 1.0f, nw + 4 * DM, WSP(bf16_t, OFF_HB)); }
        GSYNC();
        run_gemm(lds, WSP(bf16_t, OFF_HB), WSP(bf16_t, OFF_W13B), MTOK, 2 * DFF, DM, pg8::EpiGlu<true>{WSP(bf16_t, OFF_AB), DFF});
        if (l == 0) { const int rem = 1408 % (int)gridDim.x, vc = VCB(); const KPtr kp = kparams();
          if (rem == 0) convert_weights(kp, 1, 0, 528, vc, (int)gridDim.x); else if (vc >= rem) convert_weights(kp, 1, 0, 528, vc - rem, (int)gridDim.x - rem); }
        GSYNC();
        if constexpr (fusedn) { const KPtr kp = kparams(); const float* nw = kp->norm_w + (size_t)l * 6 * DM;
            run_gemm(lds, WSP(bf16_t, OFF_AB), WSP(bf16_t, OFF_W2B), MTOK, DM, DFF, pg8::EpiNormRes{kp->out, kp->out, nw + 5 * DM, 0.5f, nw + 6 * DM, l == 0 ? WSP(bf16_t, OFF_HB) : nullptr, WSP(float, OFF_SLOT), WSP(unsigned, OFF_CNT), (unsigned)(l * 6 + 4)}); }
        else { run_gemm(lds, WSP(bf16_t, OFF_AB), WSP(bf16_t, OFF_W2B), MTOK, DM, DFF, pg8::EpiBf16{WSP(bf16_t, OFF_YF1), DM, 0, nullptr, 0, nullptr, nullptr, 0}); GSYNC();
            const KPtr kp = kparams(); const float* nw = kp->norm_w + (size_t)l * 6 * DM;
            if (l == 0) row_phase<1>(nullptr, kp->out, WSP(bf16_t, OFF_YF1), nw + 5 * DM, 0.5f, nw + 6 * DM, WSP(bf16_t, OFF_HB));
            else row_phase<2>(nullptr, kp->out, WSP(bf16_t, OFF_YF1), nw + 5 * DM, 0.5f, nullptr, nullptr); }
        if (l == 0) GSYNC();
    }
}

extern "C" void kernel_launch(void* const* d_in, const int* in_sizes, int n_in, void* d_out, int out_size, void* d_ws, size_t ws_size, hipStream_t stream) {
    static int grid_blocks = 0; static const void* kfn = nullptr;
    if (grid_blocks == 0) {
        if (ws_size < WS_NEED) { fprintf(stderr, "kernel_launch: workspace too small: %zu < %zu\n", ws_size, (size_t)WS_NEED); grid_blocks = -1; return; }
        int dev = 0, cus = 0, per_cu = 0;
        (void)hipGetDevice(&dev);
        (void)hipDeviceGetAttribute(&cus, hipDeviceAttributeMultiprocessorCount, dev);
        kfn = (cus == 256) ? (const void*)fwd_megakernel<true> : (const void*)fwd_megakernel<false>;
        if (hipFuncSetAttribute((const void*)kfn, hipFuncAttributeMaxDynamicSharedMemorySize, LDS_BYTES) != hipSuccess) { fprintf(stderr, "kernel_launch: hipFuncSetAttribute failed\n"); grid_blocks = -1; return; }
        if (hipOccupancyMaxActiveBlocksPerMultiprocessor(&per_cu, (const void*)kfn, NTHR, LDS_BYTES) != hipSuccess || per_cu < 1) { fprintf(stderr, "kernel_launch: occupancy query failed (%d)\n", per_cu); grid_blocks = -1; return; }
        grid_blocks = cus * 1;
        fprintf(stderr, "kernel_launch: cus %d per_cu %d grid %d ws %zu\n", cus, per_cu, grid_blocks, ws_size);
    }
    if (grid_blocks < 0) return;
    if (hipMemsetAsync((char*)d_ws + OFF_BAR, 0, 32768 + 4096, stream) != hipSuccess) { fprintf(stderr, "kernel_launch: memset failed\n"); return; }
    Params p{};
    p.x = (const float*)d_in[0]; p.w_in = (const float*)d_in[1]; p.b_gate = (const float*)d_in[2]; p.conv_w = (const float*)d_in[3]; p.w_conv_out = (const float*)d_in[4];
    p.w_attn_out = (const float*)d_in[5]; p.lam_vec = (const float*)d_in[6]; p.subln_w = (const float*)d_in[7]; p.w_o = (const float*)d_in[8];
    p.ffn1_w13 = (const float*)d_in[9]; p.ffn1_w2 = (const float*)d_in[10]; p.ffn2_w13 = (const float*)d_in[11]; p.ffn2_w2 = (const float*)d_in[12]; p.norm_w = (const float*)d_in[13];
    p.out = (float*)d_out; p.ws = (unsigned char*)d_ws;
    void* args[] = {&p};
    hipError_t e = hipLaunchCooperativeKernel((const void*)kfn, dim3(grid_blocks), dim3(NTHR), args, LDS_BYTES, stream);
    if (e != hipSuccess) fprintf(stderr, "cooperative launch failed: %s (grid %d)\n", hipGetErrorString(e), grid_blocks);
}
```
